# Optimizing an MI355X kernel written in HIP

```python
import math
import jax, jax.numpy as jnp
from jax import lax
import numpy as np

D_MODEL = 2048
BATCH = 4
SEQ = 2048
DEPTH = 2

NORM_EPS = 1e-6
N_BRANCH = 4
BRANCH_WIDTH = D_MODEL // 2

NUM_BUCKETS = 32
MAX_DISTANCE = 128

A_QK_DIM = 64
A_V_DIM = 2 * A_QK_DIM
A_HEADS = BRANCH_WIDTH // A_V_DIM
A_WIDTH = A_HEADS * A_V_DIM
Q_BLOCK = 128

B_HEAD_DIM = 64
B_HEADS = BRANCH_WIDTH // B_HEAD_DIM
B_KV_HEADS = B_HEADS // 4
B_WIDTH = B_HEADS * B_HEAD_DIM
WINDOW = 128

C_HEAD_DIM = 64
C_HEADS = BRANCH_WIDTH // C_HEAD_DIM
C_WIDTH = C_HEADS * C_HEAD_DIM
C_GROUPS = 2
C_STATE = 128
C_CONV = 4
CHUNK = 128
C_CONV_CH = C_WIDTH + 2 * C_GROUPS * C_STATE

D_WIDTH = BRANCH_WIDTH
D_CONV = 31

IN_SPLITS = (
    2 * A_HEADS * A_QK_DIM, 2 * A_HEADS * A_QK_DIM, A_WIDTH, A_WIDTH,
    B_WIDTH, B_KV_HEADS * B_HEAD_DIM, B_KV_HEADS * B_HEAD_DIM, B_WIDTH,
    C_CONV_CH, C_HEADS, C_WIDTH,
    2 * D_WIDTH, D_WIDTH,
    N_BRANCH * D_MODEL,
)
N_IN = sum(IN_SPLITS)

kernel_name = "hybrid_diffattn_swa_ssd_conformer"


def _split_points():
    pts, acc = [], 0
    for n in IN_SPLITS[:-1]:
        acc += n
        pts.append(acc)
    return pts


def rms_norm(x, w):
    xf = x.astype(jnp.float32)
    y = xf * lax.rsqrt(jnp.mean(xf * xf, axis=-1, keepdims=True) + NORM_EPS)
    return (y * w.astype(jnp.float32)).astype(x.dtype)


def layer_norm(x, w, b):
    xf = x.astype(jnp.float32)
    mu = jnp.mean(xf, axis=-1, keepdims=True)
    xc = xf - mu
    var = jnp.mean(xc * xc, axis=-1, keepdims=True)
    y = xc * lax.rsqrt(var + NORM_EPS) * w.astype(jnp.float32) + b.astype(jnp.float32)
    return y.astype(x.dtype)


def causal_depthwise_conv(x, w, b):
    k = w.shape[0]
    y = lax.conv_general_dilated(
        x, w[:, None, :].astype(x.dtype), window_strides=(1,), padding=[(k - 1, 0)],
        dimension_numbers=("NWC", "WIO", "NWC"), feature_group_count=x.shape[-1])
    return y + b.astype(x.dtype)


def t5_bucket(dist):
    n = jnp.maximum(dist, 0)
    max_exact = NUM_BUCKETS // 2
    nf = jnp.maximum(n, 1).astype(jnp.float32)
    large = max_exact + (jnp.log(nf / max_exact) / math.log(MAX_DISTANCE / max_exact)
                         * (NUM_BUCKETS - max_exact)).astype(jnp.int32)
    large = jnp.minimum(large, NUM_BUCKETS - 1)
    return jnp.where(n < max_exact, n, large)


def diff_attention(q, k, v, lam, lam_init, subln_w, bias_table):
    b, s = q.shape[:2]
    nblk = s // Q_BLOCK
    q_blocks = (q * (A_QK_DIM ** -0.5)).reshape(
        b, nblk, Q_BLOCK, A_HEADS, 2, A_QK_DIM).swapaxes(0, 1)
    k_pos = jnp.arange(s)

    def block(args):
        qb, start = args
        q_pos = start + jnp.arange(Q_BLOCK)
        dist = q_pos[:, None] - k_pos[None, :]
        bias = bias_table[t5_bucket(dist)].astype(jnp.float32)
        bias = jnp.where((dist >= 0)[..., None], bias, -jnp.inf).transpose(2, 0, 1)
        logits = jnp.einsum("bqhmd,bkhmd->bhmqk", qb, k).astype(jnp.float32) + bias[:, None]
        p = jax.nn.softmax(logits, axis=-1)
        a = (p[:, :, 0] - lam * p[:, :, 1]).astype(v.dtype)
        return jnp.einsum("bhqk,bkhe->bqhe", a, v)

    starts = jnp.arange(nblk) * Q_BLOCK
    out = lax.map(block, (q_blocks, starts))
    out = out.swapaxes(0, 1).reshape(b, s, A_HEADS, A_V_DIM)
    out = rms_norm(out, subln_w) * (1.0 - lam_init)
    return out.reshape(b, s, A_WIDTH)


def sliding_window_attention(q, k, v, sinks, bias_table):
    b, s = q.shape[:2]
    nb = s // WINDOW
    g = B_HEADS // B_KV_HEADS
    qb = (q * (B_HEAD_DIM ** -0.5)).reshape(b, nb, WINDOW, B_KV_HEADS, g, B_HEAD_DIM)

    def band(t):
        tb = t.reshape(b, nb, WINDOW, B_KV_HEADS, B_HEAD_DIM)
        prev = jnp.concatenate([jnp.zeros_like(tb[:, :1]), tb[:, :-1]], axis=1)
        return jnp.concatenate([prev, tb], axis=2)

    kb, vb = band(k), band(v)
    qi = jnp.arange(WINDOW)[:, None]
    kj = jnp.arange(2 * WINDOW)[None, :]
    dist = WINDOW + qi - kj
    k_pos = jnp.arange(nb)[:, None, None] * WINDOW - WINDOW + kj
    valid = (dist >= 0) & (dist < WINDOW) & (k_pos >= 0)
    bias = bias_table[t5_bucket(dist)].astype(jnp.float32)
    bias = bias.transpose(2, 0, 1).reshape(B_KV_HEADS, g, WINDOW, 2 * WINDOW)
    logits = jnp.einsum("bnqhgd,bnkhd->bnhgqk", qb, kb).astype(jnp.float32) + bias
    logits = jnp.where(valid[:, None, None], logits, -jnp.inf)
    sink = sinks.reshape(B_KV_HEADS, g).astype(jnp.float32)[:, :, None, None]
    sink = jnp.broadcast_to(sink, logits.shape[:-1] + (1,))
    p = jax.nn.softmax(jnp.concatenate([logits, sink], axis=-1), axis=-1)[..., :-1]
    out = jnp.einsum("bnhgqk,bnkhd->bnqhgd", p.astype(vb.dtype), vb)
    return out.reshape(b, s, B_WIDTH)


def ssd_mixer(xbc, dt_raw, z, conv_w, conv_b, dt_bias, a_log, d_skip, norm_w):
    b, s, _ = xbc.shape
    xbc = jax.nn.silu(causal_depthwise_conv(xbc, conv_w, conv_b))
    xs, bm, cm = jnp.split(xbc, [C_WIDTH, C_WIDTH + C_GROUPS * C_STATE], axis=-1)
    nc = s // CHUNK
    e = C_HEADS // C_GROUPS
    x = xs.reshape(b, nc, CHUNK, C_GROUPS, e, C_HEAD_DIM)
    bm = bm.reshape(b, nc, CHUNK, C_GROUPS, C_STATE)
    cm = cm.reshape(b, nc, CHUNK, C_GROUPS, C_STATE)
    dt = jax.nn.softplus((dt_raw + dt_bias).astype(jnp.float32))
    a = -jnp.exp(a_log.astype(jnp.float32))
    dt_c = dt.reshape(b, nc, CHUNK, C_GROUPS, e)
    a_cum = jnp.cumsum((dt_c * a.reshape(C_GROUPS, e)).transpose(0, 3, 4, 1, 2), axis=-1)
    xdt = x * dt_c[..., None].astype(x.dtype)
    seg = a_cum[..., :, None] - a_cum[..., None, :]
    causal = jnp.tril(jnp.ones((CHUNK, CHUNK), dtype=bool))
    decay = jnp.exp(jnp.where(causal, seg, -jnp.inf)).astype(x.dtype)
    cb = jnp.einsum("bclgn,bcsgn->bgcls", cm, bm)
    y_diag = jnp.einsum("bgcls,bgecls,bcsgep->bclgep", cb, decay, xdt)
    decay_states = jnp.exp(a_cum[..., -1:] - a_cum).astype(x.dtype)
    states = jnp.einsum("bclgn,bgecl,bclgep->bcgepn", bm, decay_states, xdt)
    chunk_decay = jnp.exp(a_cum[..., -1]).astype(x.dtype)

    def step(h, inp):
        dec, st = inp
        return dec[..., None, None] * h + st, h

    h0 = jnp.zeros_like(states[:, 0])
    _, prev = lax.scan(step, h0, (jnp.moveaxis(chunk_decay, -1, 0), jnp.moveaxis(states, 1, 0)))
    prev = jnp.moveaxis(prev, 0, 1)
    y_off = jnp.einsum("bclgn,bcgepn,bgecl->bclgep", cm, prev, jnp.exp(a_cum).astype(x.dtype))
    y = (y_diag + y_off + x * d_skip.reshape(C_GROUPS, e)[..., None].astype(x.dtype))
    y = y.reshape(b, s, C_WIDTH)
    yg = (y * jax.nn.silu(z)).reshape(b, s, C_GROUPS, C_WIDTH // C_GROUPS)
    return rms_norm(yg, norm_w.reshape(C_GROUPS, -1)).reshape(b, s, C_WIDTH)


def conformer_conv(glu_in, conv_w, conv_b, ln_w, ln_b):
    val, gate = jnp.split(glu_in, 2, axis=-1)
    h = val * jax.nn.sigmoid(gate)
    h = causal_depthwise_conv(h, conv_w, conv_b)
    h = layer_norm(h, ln_w, ln_b)
    return jax.nn.silu(h)


def setup_inputs(seed: int = 0) -> dict:
    key = jax.random.key(seed)
    ks = jax.random.split(key, 24)
    f32 = jnp.float32
    nrm = lambda k, shape, sc: jax.random.normal(k, shape, f32) * sc
    dt = jnp.exp(jax.random.uniform(ks[8], (DEPTH, C_HEADS), f32,
                                    minval=math.log(1e-3), maxval=math.log(1e-1)))
    return {
        "x": nrm(ks[0], (BATCH, SEQ, D_MODEL), 1.0),
        "norm_w": 1.0 + nrm(ks[1], (DEPTH, D_MODEL), 0.02),
        "w_in": nrm(ks[2], (DEPTH, D_MODEL, N_IN), D_MODEL ** -0.5),
        "diff_lambda": nrm(ks[3], (DEPTH, 4, A_QK_DIM), 0.1),
        "diff_subln_w": 1.0 + nrm(ks[4], (DEPTH, A_V_DIM), 0.02),
        "swa_sinks": nrm(ks[5], (DEPTH, B_HEADS), 0.5),
        "ssd_conv_w": nrm(ks[6], (DEPTH, C_CONV, C_CONV_CH), C_CONV ** -0.5),
        "ssd_conv_b": nrm(ks[7], (DEPTH, C_CONV_CH), 0.02),
        "ssd_dt_bias": dt + jnp.log(-jnp.expm1(-dt)),
        "ssd_a_log": jnp.log(jax.random.uniform(ks[9], (DEPTH, C_HEADS), f32, minval=1.0, maxval=16.0)),
        "ssd_d": 1.0 + nrm(ks[10], (DEPTH, C_HEADS), 0.02),
        "ssd_norm_w": 1.0 + nrm(ks[11], (DEPTH, C_WIDTH), 0.02),
        "conf_conv_w": nrm(ks[12], (DEPTH, D_CONV, D_WIDTH), D_CONV ** -0.5),
        "conf_conv_b": nrm(ks[13], (DEPTH, D_WIDTH), 0.02),
        "conf_ln_w": 1.0 + nrm(ks[14], (DEPTH, D_WIDTH), 0.02),
        "conf_ln_b": nrm(ks[15], (DEPTH, D_WIDTH), 0.02),
        "w_branch": nrm(ks[16], (DEPTH, N_BRANCH, BRANCH_WIDTH, D_MODEL), BRANCH_WIDTH ** -0.5),
        "w_out": nrm(ks[17], (DEPTH, D_MODEL, D_MODEL), D_MODEL ** -0.5),
        "rel_bias": nrm(ks[18], (NUM_BUCKETS, A_HEADS + B_HEADS), 0.5),
        "final_norm_w": 1.0 + nrm(ks[19], (D_MODEL,), 0.02),
    }


def reference(x, norm_w, w_in, diff_lambda, diff_subln_w, swa_sinks, ssd_conv_w, ssd_conv_b,
              ssd_dt_bias, ssd_a_log, ssd_d, ssd_norm_w, conf_conv_w, conf_conv_b, conf_ln_w,
              conf_ln_b, w_branch, w_out, rel_bias, final_norm_w):
    b, s, _ = x.shape
    bias_a = rel_bias[:, :A_HEADS]
    bias_b = rel_bias[:, A_HEADS:]
    for l in range(DEPTH):
        h = rms_norm(x, norm_w[l])
        proj = jnp.einsum("bsd,dn->bsn", h, w_in[l])
        (aq, ak, av, ag, bq, bk, bv, bg, cxbc, cdt, cz, dglu, dg, mg) = jnp.split(
            proj, _split_points(), axis=-1)

        lam_init = 0.8 - 0.6 * math.exp(-0.3 * l)
        lq1, lk1, lq2, lk2 = (diff_lambda[l, i].astype(jnp.float32) for i in range(4))
        lam = jnp.exp(jnp.sum(lq1 * lk1)) - jnp.exp(jnp.sum(lq2 * lk2)) + lam_init
        ya = diff_attention(aq.reshape(b, s, A_HEADS, 2, A_QK_DIM),
                            ak.reshape(b, s, A_HEADS, 2, A_QK_DIM),
                            av.reshape(b, s, A_HEADS, A_V_DIM),
                            lam, lam_init, diff_subln_w[l], bias_a)
        ya = ya * jax.nn.silu(ag)

        g = B_HEADS // B_KV_HEADS
        yb = sliding_window_attention(bq.reshape(b, s, B_KV_HEADS, g, B_HEAD_DIM),
                                      bk.reshape(b, s, B_KV_HEADS, B_HEAD_DIM),
                                      bv.reshape(b, s, B_KV_HEADS, B_HEAD_DIM),
                                      swa_sinks[l], bias_b)
        yb = yb * jax.nn.silu(bg)

        yc = ssd_mixer(cxbc, cdt, cz, ssd_conv_w[l], ssd_conv_b[l], ssd_dt_bias[l],
                       ssd_a_log[l], ssd_d[l], ssd_norm_w[l])

        yd = conformer_conv(dglu, conf_conv_w[l], conf_conv_b[l], conf_ln_w[l], conf_ln_b[l])
        yd = yd * jax.nn.silu(dg)

        branches = jnp.stack([ya, yb, yc, yd], axis=2)
        up = jnp.einsum("bsir,ird->bsid", branches, w_branch[l])
        gates = jax.nn.sigmoid(mg.reshape(b, s, N_BRANCH, D_MODEL))
        merged = jnp.sum(gates * up, axis=2)
        x = x + jnp.einsum("bsd,de->bse", merged, w_out[l])
    return rms_norm(x, final_norm_w)
```

```cpp
#include <hip/hip_runtime.h>
#include <hip/hip_cooperative_groups.h>
#include <math.h>
#include <stdint.h>
#include <stdio.h>
namespace cg = cooperative_groups;

namespace {
constexpr int NB = 4, S = 2048, D = 2048, T = NB * S, NIN = 20496;
constexpr float EPS = 1e-6f;
constexpr int LDP = 20480;
constexpr int PA_Q = 0, PA_K = 1024, PA_V = 2048, PA_G = 3072, PB_Q = 4096, PB_K = 5120, PB_V = 5376, PB_G = 5632,
              P_XBC = 6656, P_Z = 8192, P_GLU = 9216, P_DG = 11264, P_MG = 12288;
constexpr int NPAD = 20480;
constexpr int LDBR = 4096;

typedef unsigned short bf16_t;
#define LAS __attribute__((address_space(3)))
#define GAS __attribute__((address_space(1)))
typedef short bf16x8 __attribute__((ext_vector_type(8)));
typedef float f32x4 __attribute__((ext_vector_type(4)));
typedef unsigned u32x4 __attribute__((ext_vector_type(4)));
typedef unsigned u32x2 __attribute__((ext_vector_type(2)));

__device__ __forceinline__ int launder(int v) { asm volatile("" : "+v"(v)); return v; }
__device__ __forceinline__ float bf2f(bf16_t v) { return __uint_as_float((unsigned)v << 16); }
__device__ __forceinline__ unsigned f2bf(float f) { unsigned u = __float_as_uint(f); return (u + 0x7fffu + ((u >> 16) & 1u)) >> 16; }
__device__ __forceinline__ unsigned pk2(float lo, float hi) { return f2bf(lo) | (f2bf(hi) << 16); }
__device__ __forceinline__ float sigm(float x) { return 1.f / (1.f + expf(-x)); }
__device__ __forceinline__ float sigm_fast(float x) { return __builtin_amdgcn_rcpf(1.f + __builtin_amdgcn_exp2f(-1.4426950408889634f * x)); }
__device__ __forceinline__ float silu(float x) { return x / (1.f + expf(-x)); }
__device__ __forceinline__ float wave_sum(float v) {
#pragma unroll
  for (int o = 1; o < 64; o <<= 1) v += __shfl_xor(v, o);
  return v;
}
__device__ __forceinline__ float wave_max(float v) {
#pragma unroll
  for (int o = 1; o < 64; o <<= 1) v = fmaxf(v, __shfl_xor(v, o));
  return v;
}
__device__ __forceinline__ int t5_bucket(int n) {
  if (n < 16) return n;
  float v = logf((float)n / 16.f) / logf(8.f) * 16.f;
  int l = 16 + (int)v;
  return l < 31 ? l : 31;
}

namespace pg8 {
constexpr int BM = 256, BK = 64, HALF = 128, HTB = HALF * BK * 2, STAGE_BYTES = 8 * HTB, NXCD = 8, WGM = 8;
__host__ __device__ __forceinline__ int lds_byte(int r, int c) { const int st = (r >> 4) * 2 + (c >> 5), rr = r & 15, cc = c & 31, ob = rr * 64 + cc * 2; return st * 1024 + (ob ^ (((ob >> 9) & 1) << 5)); }
__host__ __device__ __forceinline__ void stage_rc(int b, int& R, int& C) { const int st = b / 1024, sb = b % 1024, swz = sb ^ (((sb >> 9) & 1) << 5); R = (st >> 1) * 16 + swz / 64; C = (st & 1) * 32 + (swz % 64) / 2; }
__host__ __device__ __forceinline__ int perm32(int rho) { const int n = rho >> 4, i = rho & 15; return 8 * (i >> 2) + 4 * n + (i & 3); }

struct Unit { int pm, pn, aux, nt; const char* A; const char* B; };

__device__ __forceinline__ void tile_of(int L, int nM, int nN, int& pm, int& pn) {
  const int nwg = nM * nN;
  int wgid = L; { const int q = nwg / NXCD, r = nwg % NXCD, xcd = wgid % NXCD, off = wgid / NXCD; wgid = (xcd < r ? xcd * (q + 1) : r * (q + 1) + (xcd - r) * q) + off; }
  const int nig = WGM * nN, gid = wgid / nig, fm = gid * WGM, gsz = (nM - fm) < WGM ? (nM - fm) : WGM;
  pm = fm + ((wgid % nig) % gsz); pn = (wgid % nig) / gsz;
}

__device__ __forceinline__ unsigned cvt_pk_bf16(float lo, float hi) { unsigned r; asm volatile("v_cvt_pk_bf16_f32 %0, %1, %2" : "=v"(r) : "v"(lo), "v"(hi)); return r; }

template <class Epi, class Sched>
__device__ __forceinline__ void gemm_phase(LAS unsigned char* lds, const int lda, const int ldb, const Sched& S, const Epi& E) {
    const int tid = launder((int)threadIdx.x), wid = __builtin_amdgcn_readfirstlane(tid >> 6), lane = tid & 63, wr = wid >> 2, wc = wid & 3, fr = lane & 15, fq = lane >> 4;
    unsigned voffA[2], voffB[2];
#pragma unroll
    for (int i = 0; i < 2; ++i) { int R, C; stage_rc(tid * 16 + i * 8192, R, C); const int Rb = Epi::PERM ? ((R & ~31) + perm32(R & 31)) : R;
        voffA[i] = (unsigned)(R * lda + C) * 2u; voffB[i] = (unsigned)(Rb * ldb + C) * 2u; }
    const size_t kstep = (size_t)(BK * 2);
    const size_t hstepA = (size_t)HALF * lda * 2, hstepB = (size_t)HALF * ldb * 2;
    const unsigned ldsw = (unsigned)wid * 1024u;
    const int aoff = lds_byte(wr * 64 + fr, fq * 8), boff = lds_byte(wc * 32 + fr, fq * 8);
#define PG8_SA(b, h) (((b) * 2 + (h)) * HTB)
#define PG8_SB(b, h) ((4 + (b) * 2 + (h)) * HTB)
#define PG8_STAGE(bufoff, gbase, voff) do { _Pragma("unroll") for (int _i = 0; _i < 2; ++_i) \
        __builtin_amdgcn_global_load_lds((const unsigned*)((const char*)(gbase) + (voff)[_i]), (LAS unsigned*)(lds + (bufoff) + ldsw + _i * 8192), 16, 0, 0); } while (0)
#define PG8_LDA(dst, b, h) do { _Pragma("unroll") for (int m = 0; m < 4; ++m) _Pragma("unroll") for (int k = 0; k < 2; ++k) dst[m][k] = *(const LAS bf16x8*)(lds + PG8_SA(b, h) + aoff + m * 2048 + k * 1024); } while (0)
#define PG8_LDB(dst, b, h) do { _Pragma("unroll") for (int n = 0; n < 2; ++n) _Pragma("unroll") for (int k = 0; k < 2; ++k) dst[n][k] = *(const LAS bf16x8*)(lds + PG8_SB(b, h) + boff + n * 2048 + k * 1024); } while (0)
#define PG8_MMA(ai, bj, At, Bt) do { __builtin_amdgcn_s_setprio(1); _Pragma("unroll") for (int m = 0; m < 4; ++m) _Pragma("unroll") for (int n = 0; n < 2; ++n) _Pragma("unroll") for (int k = 0; k < 2; ++k) \
        acc[ai][bj][m][n] = __builtin_amdgcn_mfma_f32_16x16x32_bf16(Bt[n][k], At[m][k], acc[ai][bj][m][n], 0, 0, 0); __builtin_amdgcn_s_setprio(0); } while (0)
#define PG8_WAIT_V(n) asm volatile("s_waitcnt vmcnt(" #n ")" ::: "memory")
#define PG8_WAIT_L(n) asm volatile("s_waitcnt lgkmcnt(" #n ")" ::: "memory")
#define PG8_BAR __builtin_amdgcn_s_barrier()
#define PG8_SCHED __builtin_amdgcn_sched_barrier(0)
    Unit cur, nxt; int ui = 0;
    if (!S.next(0, cur)) return;
    f32x4 acc[2][2][4][2];
#pragma unroll
    for (int a = 0; a < 2; ++a)
#pragma unroll
        for (int b = 0; b < 2; ++b)
#pragma unroll
            for (int m = 0; m < 4; ++m)
#pragma unroll
                for (int n = 0; n < 2; ++n) acc[a][b][m][n] = (f32x4){0.f, 0.f, 0.f, 0.f};
    bf16x8 At[4][2], B0[2][2], B1[2][2];
    const char* cA = cur.A; const char* cB = cur.B;
    PG8_SCHED; PG8_STAGE(PG8_SB(0, 0), cB, voffB); PG8_SCHED; PG8_STAGE(PG8_SB(0, 1), cB + hstepB, voffB); PG8_SCHED; PG8_STAGE(PG8_SA(0, 0), cA, voffA); PG8_SCHED; PG8_STAGE(PG8_SA(0, 1), cA + hstepA, voffA); PG8_SCHED;
    if (wr == 1) PG8_BAR;
    PG8_WAIT_V(2); PG8_BAR;
    PG8_SCHED; PG8_STAGE(PG8_SB(1, 0), cB + kstep, voffB); PG8_SCHED; PG8_STAGE(PG8_SA(1, 0), cA + kstep, voffA); PG8_SCHED; PG8_STAGE(PG8_SB(1, 1), cB + hstepB + kstep, voffB); PG8_SCHED;
    PG8_WAIT_V(6); PG8_BAR;
    for (;;) {
        const bool has_next = S.next(ui + 1, nxt);
        const char* nA = has_next ? nxt.A : cA; const char* nB = has_next ? nxt.B : cB;
        const int nt = cur.nt;
        for (int t = 0; t < nt; t += 2) {
            const bool last = (t == nt - 2);
            const char* a1 = cA + (size_t)(t + 1) * kstep;
            const char* a2 = last ? nA : cA + (size_t)(t + 2) * kstep; const char* b2 = last ? nB : cB + (size_t)(t + 2) * kstep;
            const char* a3 = a2 + kstep; const char* b3 = b2 + kstep;
            PG8_LDB(B0, 0, 0); PG8_LDB(B1, 0, 1); PG8_SCHED; PG8_LDA(At, 0, 0); PG8_STAGE(PG8_SA(1, 1), a1 + hstepA, voffA);
            PG8_WAIT_V(8); PG8_WAIT_L(0); PG8_BAR; PG8_MMA(0, 0, At, B0); PG8_MMA(0, 1, At, B1); PG8_BAR; PG8_SCHED;
            PG8_LDA(At, 0, 1); PG8_STAGE(PG8_SB(0, 0), b2, voffB); PG8_STAGE(PG8_SB(0, 1), b2 + hstepB, voffB); PG8_STAGE(PG8_SA(0, 0), a2, voffA);
            PG8_WAIT_V(8); PG8_WAIT_L(0); PG8_BAR; PG8_MMA(1, 0, At, B0); PG8_MMA(1, 1, At, B1); PG8_BAR; PG8_SCHED;
            PG8_LDB(B0, 1, 0); PG8_LDB(B1, 1, 1); PG8_SCHED; PG8_LDA(At, 1, 0); PG8_STAGE(PG8_SA(0, 1), a2 + hstepA, voffA);
            PG8_WAIT_V(8); PG8_WAIT_L(0); PG8_BAR; PG8_MMA(0, 0, At, B0); PG8_MMA(0, 1, At, B1); PG8_BAR; PG8_SCHED;
            PG8_LDA(At, 1, 1); PG8_STAGE(PG8_SB(1, 0), b3, voffB); PG8_STAGE(PG8_SB(1, 1), b3 + hstepB, voffB); PG8_STAGE(PG8_SA(1, 0), a3, voffA);
            PG8_WAIT_V(8); PG8_WAIT_L(0); PG8_BAR; PG8_MMA(1, 0, At, B0); PG8_MMA(1, 1, At, B1); PG8_BAR; PG8_SCHED;
        }
        if (wr == 0) PG8_BAR;
        E(acc, cur, wr, wc, fr, fq);
        if (!has_next) break;
        if (!Epi::KEEP || cur.aux == 4) {
#pragma unroll
        for (int a = 0; a < 2; ++a)
#pragma unroll
            for (int b = 0; b < 2; ++b)
#pragma unroll
                for (int m = 0; m < 4; ++m)
#pragma unroll
                    for (int n = 0; n < 2; ++n) acc[a][b][m][n] = (f32x4){0.f, 0.f, 0.f, 0.f};
        }
        cur = nxt; cA = nA; cB = nB; ++ui;
        if (wr == 1) PG8_BAR;
    }
    PG8_WAIT_V(0);
    PG8_BAR;
#undef PG8_SA
#undef PG8_SB
#undef PG8_STAGE
#undef PG8_LDA
#undef PG8_LDB
#undef PG8_MMA
#undef PG8_WAIT_V
#undef PG8_WAIT_L
#undef PG8_BAR
#undef PG8_SCHED
}

template <class Epi, class Sched>
__device__ __forceinline__ void gemm_phase_hm(LAS unsigned char* lds, const int lda, const int ldb, const Sched& S, const Epi& E) {
    const int tid = launder((int)threadIdx.x), wid = __builtin_amdgcn_readfirstlane(tid >> 6), lane = tid & 63, wr = wid >> 2, wc = wid & 3, fr = lane & 15, fq = lane >> 4;
    unsigned voffA[2], voffB[2];
#pragma unroll
    for (int i = 0; i < 2; ++i) { int R, C; stage_rc(tid * 16 + i * 8192, R, C); const int Rb = Epi::PERM ? ((R & ~31) + perm32(R & 31)) : R;
        voffA[i] = (unsigned)(R * lda + C) * 2u; voffB[i] = (unsigned)(Rb * ldb + C) * 2u; }
    const size_t kstep = (size_t)(BK * 2);
    const size_t hstepB = (size_t)HALF * ldb * 2;
    const unsigned ldsw = (unsigned)wid * 1024u;
    const int aoff = lds_byte(wr * 64 + fr, fq * 8), boff = lds_byte(wc * 32 + fr, fq * 8);
    constexpr int SETB = 3 * HTB;
#define HM_STAGE(dst, gbase, voff) do { _Pragma("unroll") for (int _i = 0; _i < 2; ++_i) \
        __builtin_amdgcn_global_load_lds((const unsigned*)((const char*)(gbase) + (voff)[_i]), (LAS unsigned*)(lds + (dst) + ldsw + _i * 8192), 16, 0, 0); } while (0)
#define HM_STAGE_TILE(setoff, pa, pb) do { HM_STAGE((setoff), (pb), voffB); HM_STAGE((setoff) + HTB, (pb) + hstepB, voffB); HM_STAGE((setoff) + 2 * HTB, (pa), voffA); } while (0)
#define HM_WAIT_V(n) asm volatile("s_waitcnt vmcnt(" #n ")" ::: "memory")
#define HM_WAIT_L(n) asm volatile("s_waitcnt lgkmcnt(" #n ")" ::: "memory")
#define HM_BAR __builtin_amdgcn_s_barrier()
#define HM_SCHED __builtin_amdgcn_sched_barrier(0)
    Unit cur, nxt; int ui = 0;
    if (!S.next(0, cur)) return;
    f32x4 acc[2][4][2], tot[2][4][2];
#pragma unroll
    for (int b = 0; b < 2; ++b)
#pragma unroll
        for (int m = 0; m < 4; ++m)
#pragma unroll
            for (int n = 0; n < 2; ++n) { acc[b][m][n] = (f32x4){0.f, 0.f, 0.f, 0.f}; tot[b][m][n] = (f32x4){0.f, 0.f, 0.f, 0.f}; }
    bf16x8 At[4][2], B0[2][2], B1[2][2];
    const char* cA = cur.A; const char* cB = cur.B;
    HM_SCHED; HM_STAGE_TILE(0, cA, cB); HM_SCHED; HM_STAGE_TILE(SETB, cA + kstep, cB + kstep); HM_SCHED;
    if (wr == 1) HM_BAR;
    HM_WAIT_V(6); HM_BAR; HM_BAR;
    int cs = 0;
    for (;;) {
        const bool has_next = S.next(ui + 1, nxt);
        const char* nA = has_next ? nxt.A : cA; const char* nB = has_next ? nxt.B : cB;
        const int nt = cur.nt;
#pragma unroll 1
        for (int t = 0; t < nt; ++t) {
            const int t2 = t + 2;
            const char* a2 = (t2 < nt) ? cA + (size_t)t2 * kstep : nA + (size_t)(t2 - nt) * kstep;
            const char* b2 = (t2 < nt) ? cB + (size_t)t2 * kstep : nB + (size_t)(t2 - nt) * kstep;
            const int so = cs * SETB, ss = (cs == 0 ? 2 : cs - 1) * SETB;
            const LAS unsigned char* pb_ = lds + so + boff; const LAS unsigned char* pa_ = lds + so + 2 * HTB + aoff;
#pragma unroll
            for (int n = 0; n < 2; ++n)
#pragma unroll
                for (int k = 0; k < 2; ++k) { B0[n][k] = *(const LAS bf16x8*)(pb_ + n * 2048 + k * 1024); B1[n][k] = *(const LAS bf16x8*)(pb_ + HTB + n * 2048 + k * 1024); }
            HM_SCHED;
#pragma unroll
            for (int m = 0; m < 4; ++m)
#pragma unroll
                for (int k = 0; k < 2; ++k) At[m][k] = *(const LAS bf16x8*)(pa_ + m * 2048 + k * 1024);
            HM_STAGE_TILE(ss, a2, b2);
            HM_WAIT_V(6); HM_WAIT_L(0); HM_BAR;
            __builtin_amdgcn_s_setprio(1);
#pragma unroll
            for (int m = 0; m < 4; ++m)
#pragma unroll
                for (int n = 0; n < 2; ++n)
#pragma unroll
                    for (int k = 0; k < 2; ++k) acc[0][m][n] = __builtin_amdgcn_mfma_f32_16x16x32_bf16(B0[n][k], At[m][k], acc[0][m][n], 0, 0, 0);
#pragma unroll
            for (int m = 0; m < 4; ++m)
#pragma unroll
                for (int n = 0; n < 2; ++n)
#pragma unroll
                    for (int k = 0; k < 2; ++k) acc[1][m][n] = __builtin_amdgcn_mfma_f32_16x16x32_bf16(B1[n][k], At[m][k], acc[1][m][n], 0, 0, 0);
            __builtin_amdgcn_s_setprio(0);
            HM_BAR; HM_SCHED;
            cs = (cs == 2) ? 0 : cs + 1;
        }
        if (wr == 0) HM_BAR;
        E(acc, tot, cur, wr, wc, fr, fq);
        if (!has_next) break;
#pragma unroll
        for (int b = 0; b < 2; ++b)
#pragma unroll
            for (int m = 0; m < 4; ++m)
#pragma unroll
                for (int n = 0; n < 2; ++n) acc[b][m][n] = (f32x4){0.f, 0.f, 0.f, 0.f};
        cur = nxt; cA = nA; cB = nB; ++ui;
        if (wr == 1) HM_BAR;
    }
    HM_WAIT_V(0);
    HM_BAR;
#undef HM_STAGE
#undef HM_STAGE_TILE
#undef HM_WAIT_V
#undef HM_WAIT_L
#undef HM_BAR
#undef HM_SCHED
}
}

constexpr size_t AL(size_t x) { return (x + 255) & ~(size_t)255; }
constexpr size_t WS_CTL = 0, CTL_BYTES = 1u << 20;
constexpr size_t WS_WIN = WS_CTL + CTL_BYTES;
constexpr size_t WS_WBR = WS_WIN + AL((size_t)2 * NPAD * D * 2);
constexpr size_t WS_WOUT = WS_WBR + AL((size_t)2 * D * 4096 * 2);
constexpr size_t WS_WDT = WS_WOUT + AL((size_t)2 * D * D * 2);
constexpr size_t WS_H = WS_WDT + AL((size_t)2 * 16 * D * 2);
constexpr size_t WS_PROJ = WS_H + AL((size_t)T * D * 2);
constexpr size_t WS_DT = WS_PROJ + AL((size_t)T * LDP * 2);
constexpr size_t WS_BR = WS_DT + AL((size_t)T * 16 * 4);
constexpr size_t WS_SS = WS_BR + AL((size_t)T * LDBR * 2);
constexpr size_t WS_MACC = WS_SS + AL((size_t)T * 16 * 4);
constexpr size_t WS_MERGED = WS_MACC + AL((size_t)T * D * 4);
constexpr size_t WS_X1 = WS_MERGED + AL((size_t)T * D * 2);
constexpr size_t WS_X2 = WS_X1 + AL((size_t)T * D * 4);
constexpr size_t WS_CONV = WS_X2 + AL((size_t)T * D * 4);
constexpr size_t WS_DTS = WS_CONV + AL((size_t)T * 1536 * 4);
constexpr size_t WS_DTA = WS_DTS + AL((size_t)T * 16 * 4);
constexpr size_t WS_U = WS_DTA + AL((size_t)T * 32 * 4);
constexpr size_t WS_G8 = WS_U + AL((size_t)T * 1024 * 4);
constexpr size_t WS_END = WS_G8 + AL((size_t)T * 8192);

constexpr int NWAVES = 8, NTHREADS = 512;
constexpr int LDS_BYTES = 148480;

enum { PH_CONV = 0, PH_L0 = 1  , PH_PER_LAYER = 6, PH_FINAL = 13, PH_COUNT = 14 };

struct Args {
  const float* in[20];
  float* out;
  unsigned char* ws;
  int ph_lo, ph_hi;
};

__device__ __forceinline__ void conv_item(const float* __restrict__ W, int ldw, int K, bf16_t* __restrict__ WT, int mode, const float* __restrict__ kscale, int item, int nblk, int lane) {
  const int kb_i = item / nblk, nb = item % nblk, k0 = 64 * kb_i, n0 = 32 * nb;
  const int nq = lane & 7, kb = lane >> 3;
  const int np = n0 + 4 * nq;
  int nsrc = np; bool valid = true;
  if (mode == 0) { nsrc = (np < 8192) ? np : np + 16;
    if (np >= P_GLU && np < P_GLU + 2048) { const int c = np - P_GLU, k = c >> 8, cc = c & 255; nsrc = 9232 + ((cc < 128) ? (128 * k + cc) : (1024 + 128 * k + (cc - 128))); } }
  f32x4 v[8];
#pragma unroll
  for (int j = 0; j < 8; ++j) {
    const int k = k0 + 8 * kb + j;
    v[j] = valid ? *(const f32x4*)(W + (size_t)k * ldw + nsrc) : (f32x4){0.f, 0.f, 0.f, 0.f};
    if (mode == 2 && k >= 2048 && k < 3072) v[j] = v[j] * kscale[k - 2048];
  }
#pragma unroll
  for (int i = 0; i < 4; ++i) {
    u32x4 o; o.x = pk2(v[0][i], v[1][i]); o.y = pk2(v[2][i], v[3][i]); o.z = pk2(v[4][i], v[5][i]); o.w = pk2(v[6][i], v[7][i]);
    *(u32x4*)(WT + (size_t)(np + i) * K + k0 + 8 * kb) = o;
  }
}

__device__ __forceinline__ void norm_row_bf16(const float* __restrict__ xrow, const float* __restrict__ w, bf16_t* __restrict__ orow, int lane) {
  const f32x4* xr = (const f32x4*)xrow + lane; const f32x4* wr = (const f32x4*)w + lane;
  f32x4 v[8]; float s = 0.f;
#pragma unroll
  for (int j = 0; j < 8; ++j) { v[j] = xr[64 * j]; s += (v[j].x * v[j].x + v[j].y * v[j].y) + (v[j].z * v[j].z + v[j].w * v[j].w); }
  const float r = rsqrtf(wave_sum(s) * (1.f / D) + EPS);
  u32x2* o8 = (u32x2*)orow + lane;
#pragma unroll
  for (int j = 0; j < 8; ++j) { const f32x4 ww = wr[64 * j]; u32x2 o; o.x = pk2(v[j].x * r * ww.x, v[j].y * r * ww.y); o.y = pk2(v[j].z * r * ww.z, v[j].w * r * ww.w); o8[64 * j] = o; }
}
__device__ __forceinline__ void norm_row_f32(const float* __restrict__ xrow, const float* __restrict__ w, float* __restrict__ orow, int lane) {
  const f32x4* xr = (const f32x4*)xrow + lane; const f32x4* wr = (const f32x4*)w + lane;
  f32x4 v[8]; float s = 0.f;
#pragma unroll
  for (int j = 0; j < 8; ++j) { v[j] = xr[64 * j]; s += (v[j].x * v[j].x + v[j].y * v[j].y) + (v[j].z * v[j].z + v[j].w * v[j].w); }
  const float r = rsqrtf(wave_sum(s) * (1.f / D) + EPS);
  f32x4* o = (f32x4*)orow + lane;
#pragma unroll
  for (int j = 0; j < 8; ++j) { const f32x4 ww = wr[64 * j]; o[64 * j] = (f32x4){v[j].x * r * ww.x, v[j].y * r * ww.y, v[j].z * r * ww.z, v[j].w * r * ww.w}; }
}

struct SchedInproj {
  const char* A; const char* B; int G, c;
  __device__ __forceinline__ bool next(int i, pg8::Unit& u) const {
    const int L = i * G + c; if (L >= 32 * 80) return false;
    pg8::tile_of(L, 32, 80, u.pm, u.pn); u.aux = 0; u.nt = D / 64;
    u.A = A + (size_t)u.pm * 256 * D * 2; u.B = B + (size_t)u.pn * 256 * D * 2; return true;
  }
};
struct SchedMergeHM {
  const char* A; const char* B; int G, c;
  __device__ __forceinline__ bool next(int i, pg8::Unit& u) const {
    const int L = (i / 5) * G + c; if (L >= 64 * 8) return false;
    const int p = i % 5;
    int pm2, pn; pg8::tile_of(L >> 1, 32, 8, pm2, pn); u.pm = 2 * pm2 + (L & 1); u.pn = pn; u.aux = p;
    const int koff = (p == 0) ? 0 : (p == 1) ? 1024 : (p == 2) ? 2048 : (p == 3) ? 2560 : 3072;
    u.nt = (p == 2 || p == 3) ? 8 : 16;
    u.A = A + ((size_t)u.pm * 128 * LDBR + koff) * 2; u.B = B + ((size_t)u.pn * 256 * 4096 + koff) * 2; return true;
  }
};
struct EpiMergeHM {
  static constexpr bool PERM = true;
  const unsigned char* G8; const float* SS; bf16_t* MERGED;
  __device__ __forceinline__ void operator()(const f32x4 (&acc)[2][4][2], f32x4 (&tot)[2][4][2], const pg8::Unit& u, int wr, int wc, int fr_, int fq_) const {
    const int fr = launder(fr_), fq = launder(fq_);
    const int p = u.aux, bi = (p <= 2) ? p : p - 1;
    const int row0 = u.pm * 128 + wr * 64 + fr, col0 = u.pn * 256 + wc * 32 + 8 * fq;
    u32x2 gw[4][2];
#pragma unroll
    for (int m = 0; m < 4; ++m)
#pragma unroll
      for (int bj = 0; bj < 2; ++bj) gw[m][bj] = *(const u32x2*)(G8 + (size_t)(row0 + m * 16) * 8192 + bi * 2048 + col0 + bj * 128);
#pragma unroll
    for (int m = 0; m < 4; ++m) {
      const int row = row0 + m * 16;
      float rs = 1.f / 255.f;
      if (p == 2 || p == 3) { const f32x4 s0 = *(const f32x4*)(SS + (size_t)row * 16 + (p - 2) * 8), s1 = *(const f32x4*)(SS + (size_t)row * 16 + (p - 2) * 8 + 4);
        rs = rsqrtf(((s0[0] + s0[1]) + (s0[2] + s0[3]) + (s1[0] + s1[1]) + (s1[2] + s1[3])) * (1.f / 512.f) + EPS) * (1.f / 255.f); }
#pragma unroll
      for (int bj = 0; bj < 2; ++bj) {
        const u32x2 g = gw[m][bj];
        f32x4 v0 = acc[bj][m][0], v1 = acc[bj][m][1];
        v0[0] *= rs * (float)(g.x & 0xffu); v0[1] *= rs * (float)((g.x >> 8) & 0xffu); v0[2] *= rs * (float)((g.x >> 16) & 0xffu); v0[3] *= rs * (float)(g.x >> 24);
        v1[0] *= rs * (float)(g.y & 0xffu); v1[1] *= rs * (float)((g.y >> 8) & 0xffu); v1[2] *= rs * (float)((g.y >> 16) & 0xffu); v1[3] *= rs * (float)(g.y >> 24);
        v0 += tot[bj][m][0]; v1 += tot[bj][m][1];
        if (p < 4) { tot[bj][m][0] = v0; tot[bj][m][1] = v1; }
        else {
          u32x4 w; w.x = pg8::cvt_pk_bf16(v0[0], v0[1]); w.y = pg8::cvt_pk_bf16(v0[2], v0[3]); w.z = pg8::cvt_pk_bf16(v1[0], v1[1]); w.w = pg8::cvt_pk_bf16(v1[2], v1[3]);
          *(u32x4*)(MERGED + (size_t)row * D + col0 + bj * 128) = w;
          tot[bj][m][0] = (f32x4){0.f, 0.f, 0.f, 0.f}; tot[bj][m][1] = (f32x4){0.f, 0.f, 0.f, 0.f};
        }
      }
    }
  }
};
struct SchedMergeMP {
  const char* A; const char* B; int G, c;
  __device__ __forceinline__ bool next(int i, pg8::Unit& u) const {
    const int L = (i / 5) * G + c; if (L >= 32 * 8) return false;
    const int p = i % 5;
    pg8::tile_of(L, 32, 8, u.pm, u.pn); u.aux = p;
    const int koff = (p == 0) ? 0 : (p == 1) ? 1024 : (p == 2) ? 2048 : (p == 3) ? 2560 : 3072;
    u.nt = (p == 2 || p == 3) ? 8 : 16;
    u.A = A + ((size_t)u.pm * 256 * LDBR + koff) * 2; u.B = B + ((size_t)u.pn * 256 * 4096 + koff) * 2; return true;
  }
};
__device__ __forceinline__ float ub0(unsigned v) { return (float)(v & 0xffu); }
__device__ __forceinline__ float ub1(unsigned v) { return (float)((v >> 8) & 0xffu); }
__device__ __forceinline__ float ub2(unsigned v) { return (float)((v >> 16) & 0xffu); }
__device__ __forceinline__ float ub3(unsigned v) { return (float)(v >> 24); }
struct EpiMergeMP {
  static constexpr bool PERM = true, KEEP = true;
  const unsigned char* G8; const float* SS; bf16_t* MERGED;
  __device__ __forceinline__ float rs_of(int row, int g) const {
    const f32x4 s0 = *(const f32x4*)(SS + (size_t)row * 16 + g * 8), s1 = *(const f32x4*)(SS + (size_t)row * 16 + g * 8 + 4);
    return rsqrtf(((s0[0] + s0[1]) + (s0[2] + s0[3]) + (s1[0] + s1[1]) + (s1[2] + s1[3])) * (1.f / 512.f) + EPS);
  }
  __device__ __forceinline__ void operator()(f32x4 (&acc)[2][2][4][2], const pg8::Unit& u, int wr, int wc, int fr_, int fq_) const {
    const int fr = launder(fr_), fq = launder(fq_);
    const int p = u.aux;
    const int row0 = u.pm * 256 + wr * 64 + fr, col0 = u.pn * 256 + wc * 32 + 8 * fq;
    const int pa = (p == 0) ? 0 : (p == 1) ? 1 : (p == 4) ? 3 : 2;
#pragma unroll
    for (int ai = 0; ai < 2; ++ai) {
      u32x2 ga[4][2], gb[4][2];
      if (p != 2) {
#pragma unroll
        for (int m = 0; m < 4; ++m)
#pragma unroll
          for (int bj = 0; bj < 2; ++bj) {
            const unsigned char* gp = G8 + (size_t)(row0 + ai * 128 + m * 16) * 8192 + col0 + bj * 128;
            ga[m][bj] = *(const u32x2*)(gp + pa * 2048);
            gb[m][bj] = *(const u32x2*)(gp + (p == 4 ? pa : pa + 1) * 2048);
          }
      }
      __builtin_amdgcn_sched_barrier(0);
#pragma unroll
      for (int m = 0; m < 4; ++m) {
        const int row = row0 + ai * 128 + m * 16;
        float rf = (p == 4) ? (1.f / 255.f) : 1.f;
        if (p >= 1 && p <= 3) { const float r0 = rs_of(row, 0), r1 = rs_of(row, 1); rf = (p == 1) ? __builtin_amdgcn_rcpf(r0) : (p == 2) ? r0 * __builtin_amdgcn_rcpf(r1) : r1; }
#pragma unroll
        for (int bj = 0; bj < 2; ++bj) {
          float f[8];
          if (p != 2) {
            const u32x2 a = ga[m][bj], b = gb[m][bj];
            const float d0 = (p == 4) ? 1.f : __builtin_amdgcn_rcpf(ub0(b.x)), d1 = (p == 4) ? 1.f : __builtin_amdgcn_rcpf(ub1(b.x)), d2 = (p == 4) ? 1.f : __builtin_amdgcn_rcpf(ub2(b.x)), d3 = (p == 4) ? 1.f : __builtin_amdgcn_rcpf(ub3(b.x));
            const float d4 = (p == 4) ? 1.f : __builtin_amdgcn_rcpf(ub0(b.y)), d5 = (p == 4) ? 1.f : __builtin_amdgcn_rcpf(ub1(b.y)), d6 = (p == 4) ? 1.f : __builtin_amdgcn_rcpf(ub2(b.y)), d7 = (p == 4) ? 1.f : __builtin_amdgcn_rcpf(ub3(b.y));
            f[0] = rf * ub0(a.x) * d0; f[1] = rf * ub1(a.x) * d1; f[2] = rf * ub2(a.x) * d2; f[3] = rf * ub3(a.x) * d3;
            f[4] = rf * ub0(a.y) * d4; f[5] = rf * ub1(a.y) * d5; f[6] = rf * ub2(a.y) * d6; f[7] = rf * ub3(a.y) * d7;
          } else {
#pragma unroll
            for (int j = 0; j < 8; ++j) f[j] = rf;
          }
          acc[ai][bj][m][0] = acc[ai][bj][m][0] * (f32x4){f[0], f[1], f[2], f[3]};
          acc[ai][bj][m][1] = acc[ai][bj][m][1] * (f32x4){f[4], f[5], f[6], f[7]};
          if (p == 4) {
            const f32x4 v0 = acc[ai][bj][m][0], v1 = acc[ai][bj][m][1];
            u32x4 w; w.x = pg8::cvt_pk_bf16(v0[0], v0[1]); w.y = pg8::cvt_pk_bf16(v0[2], v0[3]); w.z = pg8::cvt_pk_bf16(v1[0], v1[1]); w.w = pg8::cvt_pk_bf16(v1[2], v1[3]);
            *(u32x4*)(MERGED + (size_t)row * D + col0 + bj * 128) = w;
          }
        }
      }
      __builtin_amdgcn_sched_barrier(0);
    }
  }
};
struct SchedOut {
  const char* A; const char* B; int G, c;
  __device__ __forceinline__ bool next(int i, pg8::Unit& u) const {
    const int L = i * G + c; if (L >= 32 * 8) return false;
    pg8::tile_of(L, 32, 8, u.pm, u.pn); u.aux = 0; u.nt = D / 64;
    u.A = A + (size_t)u.pm * 256 * D * 2; u.B = B + (size_t)u.pn * 256 * D * 2; return true;
  }
};

struct EpiProj {
  static constexpr bool PERM = true, KEEP = false;
  bf16_t* P; unsigned char* G8;
  __device__ __forceinline__ void operator()(const f32x4 (&acc)[2][2][4][2], const pg8::Unit& u, int wr, int wc, int fr_, int fq_) const {
    const int fr = launder(fr_), fq = launder(fq_);
    const int row0 = u.pm * 256 + wr * 64 + fr;
    if (u.pn >= P_GLU / 256 && u.pn < P_GLU / 256 + 8) {
      const int colg = P_GLU + 128 * (u.pn - P_GLU / 256) + wc * 32 + 8 * fq;
#pragma unroll
      for (int ai = 0; ai < 2; ++ai)
#pragma unroll
        for (int m = 0; m < 4; ++m) {
          const f32x4 v0 = acc[ai][0][m][0], v1 = acc[ai][0][m][1], g0 = acc[ai][1][m][0], g1 = acc[ai][1][m][1];
          u32x4 w; w.x = pg8::cvt_pk_bf16(v0[0] * sigm_fast(g0[0]), v0[1] * sigm_fast(g0[1])); w.y = pg8::cvt_pk_bf16(v0[2] * sigm_fast(g0[2]), v0[3] * sigm_fast(g0[3]));
          w.z = pg8::cvt_pk_bf16(v1[0] * sigm_fast(g1[0]), v1[1] * sigm_fast(g1[1])); w.w = pg8::cvt_pk_bf16(v1[2] * sigm_fast(g1[2]), v1[3] * sigm_fast(g1[3]));
          *(u32x4*)(P + (size_t)(row0 + ai * 128 + m * 16) * LDP + colg) = w;
        }
      return;
    }
    if (u.pn >= P_MG / 256) {
      const int colg = (u.pn - P_MG / 256) * 256 + wc * 32 + 8 * fq;
#pragma unroll
      for (int ai = 0; ai < 2; ++ai)
#pragma unroll
        for (int m = 0; m < 4; ++m)
#pragma unroll
          for (int bj = 0; bj < 2; ++bj) {
            const f32x4 v0 = acc[ai][bj][m][0], v1 = acc[ai][bj][m][1];
            unsigned q[8];
#pragma unroll
            for (int j = 0; j < 4; ++j) { q[j] = (unsigned)fmaxf(__builtin_rintf(255.f * sigm_fast(v0[j])), 1.f); q[4 + j] = (unsigned)fmaxf(__builtin_rintf(255.f * sigm_fast(v1[j])), 1.f); }
            u32x2 w; w.x = q[0] | (q[1] << 8) | (q[2] << 16) | (q[3] << 24); w.y = q[4] | (q[5] << 8) | (q[6] << 16) | (q[7] << 24);
            *(u32x2*)(G8 + (size_t)(row0 + ai * 128 + m * 16) * 8192 + colg + bj * 128) = w;
          }
      return;
    }
    const int col0 = u.pn * 256 + wc * 32 + 8 * fq;
#pragma unroll
    for (int ai = 0; ai < 2; ++ai)
#pragma unroll
      for (int m = 0; m < 4; ++m) { bf16_t* rowp = P + (size_t)(row0 + ai * 128 + m * 16) * LDP + col0;
#pragma unroll
        for (int bj = 0; bj < 2; ++bj) { const f32x4 v0 = acc[ai][bj][m][0], v1 = acc[ai][bj][m][1];
          u32x4 w; w.x = pg8::cvt_pk_bf16(v0[0], v0[1]); w.y = pg8::cvt_pk_bf16(v0[2], v0[3]); w.z = pg8::cvt_pk_bf16(v1[0], v1[1]); w.w = pg8::cvt_pk_bf16(v1[2], v1[3]);
          *(u32x4*)(rowp + bj * 128) = w; } }
  }
};
struct EpiOut {
  static constexpr bool PERM = false, KEEP = false;
  const float* xin; float* xout;
  __device__ __forceinline__ void operator()(const f32x4 (&acc)[2][2][4][2], const pg8::Unit& u, int wr, int wc, int fr_, int fq_) const {
    const int fr = launder(fr_), fq = launder(fq_);
    const int row0 = u.pm * 256 + wr * 64 + fr, col0 = u.pn * 256 + wc * 32 + 4 * fq;
#pragma unroll
    for (int ai = 0; ai < 2; ++ai) {
      f32x4 b[4][2][2];
#pragma unroll
      for (int m = 0; m < 4; ++m) { const size_t off = (size_t)(row0 + ai * 128 + m * 16) * D + col0;
#pragma unroll
        for (int bj = 0; bj < 2; ++bj)
#pragma unroll
          for (int n = 0; n < 2; ++n) b[m][bj][n] = *(const f32x4*)(xin + off + bj * 128 + n * 16); }
      __builtin_amdgcn_sched_barrier(0);
#pragma unroll
      for (int m = 0; m < 4; ++m) { const size_t off = (size_t)(row0 + ai * 128 + m * 16) * D + col0;
#pragma unroll
        for (int bj = 0; bj < 2; ++bj)
#pragma unroll
          for (int n = 0; n < 2; ++n) *(f32x4*)(xout + off + bj * 128 + n * 16) = b[m][bj][n] + acc[ai][bj][m][n]; }
      __builtin_amdgcn_sched_barrier(0);
    }
  }
};

#define REP_CONVW 1
#define REP_INPROJ 1
#define REP_MIX 1
#define REP_MERGE 1
#define REP_OUT 1
#define REP_PREMIX 1
#ifndef FAST_A
#define FAST_A 1
#endif
#ifndef FAST_B
#define FAST_B 1
#endif
#ifndef FAST_D
#define FAST_D 1
#endif
#ifndef FAST_C
#define FAST_C 1
#endif
typedef float f32x16 __attribute__((ext_vector_type(16)));
constexpr float LOG2E = 1.4426950408889634f;
__device__ __forceinline__ int t5_bucket_fast(int n) {
  if (n < 16) return n;
  const float v = __builtin_amdgcn_logf((float)n * 0.0625f) * (16.f / 3.f);
  const int l = 16 + (int)v;
  return l < 31 ? l : 31;
}
constexpr float QSCALE = 0.125f * LOG2E;
__device__ __forceinline__ int crow(int r, int hi) { return (r & 3) + 8 * (r >> 2) + 4 * hi; }
__device__ __forceinline__ float ex2(float x) { return __builtin_amdgcn_exp2f(x); }
__device__ __forceinline__ float silu_fast(float x) { return x * __builtin_amdgcn_rcpf(1.f + ex2(-LOG2E * x)); }
__device__ __forceinline__ unsigned cvtpk(float lo, float hi) { unsigned r; asm("v_cvt_pk_bf16_f32 %0, %1, %2" : "=v"(r) : "v"(lo), "v"(hi)); return r; }
__device__ __forceinline__ float bflo(unsigned w) { return __uint_as_float(w << 16); }
__device__ __forceinline__ float bfhi(unsigned w) { return __uint_as_float(w & 0xffff0000u); }

__device__ __forceinline__ void load_qf(bf16x8 (&qf)[4], const bf16_t* qrow  ) {
#pragma unroll
  for (int d0 = 0; d0 < 4; ++d0) {
    const u32x4 w = *(const u32x4*)(qrow + 16 * d0);
    u32x4 o;
    o.x = cvtpk(bflo(w.x) * QSCALE, bfhi(w.x) * QSCALE); o.y = cvtpk(bflo(w.y) * QSCALE, bfhi(w.y) * QSCALE);
    o.z = cvtpk(bflo(w.z) * QSCALE, bfhi(w.z) * QSCALE); o.w = cvtpk(bflo(w.w) * QSCALE, bfhi(w.w) * QSCALE);
    qf[d0] = __builtin_bit_cast(bf16x8, o);
  }
}
__device__ __forceinline__ void st_tile(f32x16& p0, f32x16& p1, const LAS unsigned char* kb, const int kstride, const bf16x8 (&qf)[4], const float cinit) {
#pragma unroll
  for (int r = 0; r < 16; ++r) { p0[r] = cinit; p1[r] = cinit; }
#pragma unroll
  for (int d0 = 0; d0 < 4; ++d0) {
    const bf16x8 a0 = *(const LAS bf16x8*)(kb + d0 * 32);
    const bf16x8 a1 = *(const LAS bf16x8*)(kb + 32 * kstride + d0 * 32);
    p0 = __builtin_amdgcn_mfma_f32_32x32x16_bf16(a0, qf[d0], p0, 0, 0, 0);
    p1 = __builtin_amdgcn_mfma_f32_32x32x16_bf16(a1, qf[d0], p1, 0, 0, 0);
  }
}
template <int SS_>
__device__ __forceinline__ bf16x8 pack8(const f32x16& p) {
  u32x4 w; w.x = cvtpk(p[8 * SS_ + 0], p[8 * SS_ + 1]); w.y = cvtpk(p[8 * SS_ + 2], p[8 * SS_ + 3]); w.z = cvtpk(p[8 * SS_ + 4], p[8 * SS_ + 5]); w.w = cvtpk(p[8 * SS_ + 6], p[8 * SS_ + 7]);
  return __builtin_bit_cast(bf16x8, w);
}
template <int NE>
__device__ __forceinline__ void pv_step(f32x16 (&o)[NE], const bf16x8 pk, const LAS unsigned char* vt, const int vstride) {
#pragma unroll
  for (int je = 0; je < NE; ++je) {
    const u32x2 lo = *(const LAS u32x2*)(vt + je * 32 * vstride);
    const u32x2 hi2 = *(const LAS u32x2*)(vt + je * 32 * vstride + 16);
    const u32x4 a = (u32x4){lo.x, lo.y, hi2.x, hi2.y};
    o[je] = __builtin_amdgcn_mfma_f32_32x32x16_bf16(__builtin_bit_cast(bf16x8, a), pk, o[je], 0, 0, 0);
  }
}
template <int NE>
__device__ __forceinline__ void softmax_pv(f32x16& p0, f32x16& p1, float& m, float& l, f32x16 (&o)[NE], const LAS unsigned char* vt, const int vstride) {
  float mx = fmaxf(p0[0], p1[0]);
#pragma unroll
  for (int r = 1; r < 16; ++r) mx = fmaxf(mx, fmaxf(p0[r], p1[r]));
  mx = fmaxf(mx, __shfl_xor(mx, 32));
  const float mn = fmaxf(m, mx);
  const float alpha = ex2(m - mn);
  m = mn;
  float sum = 0.f;
#pragma unroll
  for (int r = 0; r < 16; ++r) { p0[r] = ex2(p0[r] - mn); p1[r] = ex2(p1[r] - mn); sum += p0[r] + p1[r]; }
  l = l * alpha + sum;
#pragma unroll
  for (int je = 0; je < NE; ++je) o[je] = o[je] * alpha;
  pv_step<NE>(o, pack8<0>(p0), vt, vstride);
  pv_step<NE>(o, pack8<1>(p0), vt + 32, vstride);
  pv_step<NE>(o, pack8<0>(p1), vt + 64, vstride);
  pv_step<NE>(o, pack8<1>(p1), vt + 96, vstride);
}

__device__ __forceinline__ unsigned off_b(unsigned row, unsigned ch) { return 256u * row + 16u * (ch ^ (((row & 3u) << 2) | ((row >> 2) & 3u))); }
struct LaneB { unsigned xr, q, T0, T1, N0, N1; };
__device__ __forceinline__ LaneB lane_b(int lane) {
  const unsigned h = lane >> 5, blk = (lane >> 4) & 1, q = (lane & 15) >> 2, p = lane & 3, ch0 = 2 * blk + (p >> 1), r32 = lane & 31;
  LaneB L; L.q = q; L.xr = ((r32 & 3) << 2) | ((r32 >> 2) & 3);
  L.T0 = 256 * (4 * h + q) + 16 * (ch0 ^ h) + 8 * (p & 1);
  L.T1 = 256 * (8 + 4 * h + q) + 16 * (ch0 ^ (2 + h)) + 8 * (p & 1);
  L.N0 = 256 * (8 * h + q) + 16 * (ch0 ^ ((2 * h) & 3)) + 8 * (p & 1);
  L.N1 = 256 * (8 * h + 4 + q) + 16 * (ch0 ^ ((2 * h + 1) & 3)) + 8 * (p & 1);
  return L;
}
typedef short v4i16_t __attribute__((ext_vector_type(4)));
__device__ __forceinline__ u32x2 tr_rd(const LAS unsigned char* p) { return __builtin_bit_cast(u32x2, __builtin_amdgcn_ds_read_tr16_b64_v4i16((LAS v4i16_t*)p)); }
__device__ __forceinline__ void st_tile_b(f32x16& p0, f32x16& p1, const LAS unsigned char* kt, const unsigned (&ko)[4], const bf16x8 (&qf)[4], const float cinit) {
  bf16x8 a[8];
#pragma unroll
  for (int d0 = 0; d0 < 4; ++d0) { a[2 * d0] = *(const LAS bf16x8*)(kt + ko[d0]); a[2 * d0 + 1] = *(const LAS bf16x8*)(kt + 8192 + ko[d0]); }
#pragma unroll
  for (int r = 0; r < 16; ++r) { p0[r] = cinit; p1[r] = cinit; }
  __builtin_amdgcn_sched_barrier(0);
#pragma unroll
  for (int d0 = 0; d0 < 4; ++d0) {
    p0 = __builtin_amdgcn_mfma_f32_32x32x16_bf16(a[2 * d0], qf[d0], p0, 0, 0, 0);
    p1 = __builtin_amdgcn_mfma_f32_32x32x16_bf16(a[2 * d0 + 1], qf[d0], p1, 0, 0, 0);
  }
}
template <int NE>
__device__ __forceinline__ void pv_tr4(f32x16 (&o)[NE], const bf16x8 (&pk)[4], const LAS unsigned char* vb, const unsigned (&a0)[NE], const unsigned (&a1)[NE]) {
  u32x2 f[2][NE][2];
#pragma unroll
  for (int je = 0; je < NE; ++je) { f[0][je][0] = tr_rd(vb + a0[je]); f[0][je][1] = tr_rd(vb + a1[je]); }
#pragma unroll
  for (int s = 0; s < 4; ++s) {
    if (s < 3) {
#pragma unroll
      for (int je = 0; je < NE; ++je) { f[(s + 1) & 1][je][0] = tr_rd(vb + 4096 * (s + 1) + a0[je]); f[(s + 1) & 1][je][1] = tr_rd(vb + 4096 * (s + 1) + a1[je]); }
    }
    __builtin_amdgcn_sched_barrier(0);
#pragma unroll
    for (int je = 0; je < NE; ++je) {
      const u32x4 a = (u32x4){f[s & 1][je][0].x, f[s & 1][je][0].y, f[s & 1][je][1].x, f[s & 1][je][1].y};
      o[je] = __builtin_amdgcn_mfma_f32_32x32x16_bf16(__builtin_bit_cast(bf16x8, a), pk[s], o[je], 0, 0, 0);
    }
    __builtin_amdgcn_sched_barrier(0);
  }
}
template <int NE>
__device__ __forceinline__ void softmax_pv_tr(f32x16& p0, f32x16& p1, float& m, float& l, f32x16 (&o)[NE], const LAS unsigned char* vb, const unsigned (&a0)[NE], const unsigned (&a1)[NE]) {
  float mxa = fmaxf(fmaxf(p0[0], p1[0]), fmaxf(p0[1], p1[1])), mxb = fmaxf(fmaxf(p0[2], p1[2]), fmaxf(p0[3], p1[3]));
#pragma unroll
  for (int r = 4; r < 16; r += 2) { mxa = fmaxf(fmaxf(mxa, p0[r]), p1[r]); mxb = fmaxf(fmaxf(mxb, p0[r + 1]), p1[r + 1]); }
  float mx = fmaxf(mxa, mxb);
  mx = fmaxf(mx, __shfl_xor(mx, 32));
  if (!__all(mx <= m + 8.f)) {
    const float mn = fmaxf(m, mx);
    const float alpha = ex2(m - mn);
    m = mn; l = l * alpha;
#pragma unroll
    for (int je = 0; je < NE; ++je) o[je] = o[je] * alpha;
  }
  float s0 = 0.f, s1 = 0.f;
#pragma unroll
  for (int r = 0; r < 16; ++r) { p0[r] = ex2(p0[r] - m); p1[r] = ex2(p1[r] - m); s0 += p0[r]; s1 += p1[r]; }
  l += s0 + s1;
  const bf16x8 pk[4] = {pack8<0>(p0), pack8<1>(p0), pack8<0>(p1), pack8<1>(p1)};
  pv_tr4<NE>(o, pk, vb, a0, a1);
}

constexpr int A_SLOT = 32768, A_TAB = 3 * A_SLOT;
__device__ __forceinline__ void glds16(const void* g, LAS unsigned char* l) { __builtin_amdgcn_global_load_lds((const unsigned*)g, (LAS unsigned*)l, 16, 0, 0); }
__device__ __forceinline__ void unit_A(LAS unsigned char* lds, const bf16_t* __restrict__ P, const float* __restrict__ rel_bias, const float* __restrict__ subln_w,
                                       const float lam, const float lam_init, bf16_t* __restrict__ BR, const int unit) {
  const int tid = launder((int)threadIdx.x), lane = tid & 63, wave = __builtin_amdgcn_readfirstlane(tid >> 6), r32 = lane & 31, hi = lane >> 5;
  const int qb = 15 - unit / 32, bh = unit % 32, b = bh >> 3, h = bh & 7;
  const int rg = wave >> 1, m = wave & 1;
  if (wave >= 4) __builtin_amdgcn_s_setprio(1);
  const size_t rowbase = (size_t)b * S;
  const int ntiles = 2 * qb + 2;
  const bf16_t* ksrc[2]; const bf16_t* vsrc[2];
#pragma unroll
  for (int i = 0; i < 2; ++i) {
    const int row = 4 * (2 * wave + i) + (lane >> 4), pos = lane & 15, ch = pos ^ (((row & 3) << 2) | ((row >> 2) & 3));
    ksrc[i] = P + (rowbase + row) * LDP + PA_K + h * 128 + ch * 8;
    vsrc[i] = P + (rowbase + row) * LDP + PA_V + h * 128 + ch * 8;
  }
#define A_DMA(j, slot) do { const size_t o_ = (size_t)(j) * 64 * LDP; LAS unsigned char* d_ = lds + (slot) * A_SLOT + (2 * wave) * 1024; \
    glds16(ksrc[0] + o_, d_); glds16(ksrc[1] + o_, d_ + 1024); glds16(vsrc[0] + o_, d_ + 16384); glds16(vsrc[1] + o_, d_ + 16384 + 1024); } while (0)
  A_DMA(0, 0); A_DMA(1, 1);
  LAS float* tab = (LAS float*)(lds + A_TAB);
  if (tid < 320) { const int d = tid - 96; tab[tid] = d < 0 ? -INFINITY : rel_bias[t5_bucket_fast(d < 128 ? d : 128) * 24 + h] * LOG2E; }
  const float b31 = rel_bias[31 * 24 + h] * LOG2E;
  const int qrow = 128 * qb + 32 * rg + r32;
  bf16x8 qf[4];
  load_qf(qf, P + (rowbase + qrow) * LDP + PA_Q + h * 128 + m * 64 + 8 * hi);
  const LaneB LB = lane_b(lane);
  unsigned ko[4], va0[4], va1[4];
#pragma unroll
  for (int d0 = 0; d0 < 4; ++d0) ko[d0] = 256u * r32 + 16u * ((unsigned)(8 * m + 2 * d0 + hi) ^ LB.xr);
#pragma unroll
  for (int je = 0; je < 4; ++je) { va0[je] = LB.T0 + 64u * ((unsigned)je ^ LB.q); va1[je] = LB.T1 + 64u * ((unsigned)je ^ LB.q); }
  float mst = -INFINITY, lst = 0.f;
  f32x16 o[4];
#pragma unroll
  for (int je = 0; je < 4; ++je)
#pragma unroll
    for (int r = 0; r < 16; ++r) o[je][r] = 0.f;
  const int qmin = 128 * qb + 32 * rg;
  int slot = 0;
  for (int j = 0; j < ntiles; ++j) {
    if (j + 1 < ntiles) asm volatile("s_waitcnt vmcnt(4) lgkmcnt(0)" ::: "memory"); else asm volatile("s_waitcnt vmcnt(0) lgkmcnt(0)" ::: "memory");
    __builtin_amdgcn_s_barrier();
    asm volatile("" ::: "memory");
    if (j + 2 < ntiles) { const int s2 = slot >= 1 ? slot - 1 : 2; A_DMA(j + 2, s2); }
    if (64 * j <= qmin + 31) {
      const LAS unsigned char* kt = lds + slot * A_SLOT;
      const bool far = (qmin - (64 * j + 63)) >= 128;
      f32x16 p0, p1;
      st_tile_b(p0, p1, kt, ko, qf, far ? b31 : 0.f);
      if (!far) {
        const LAS float* tb = tab + (qrow - 64 * j - 4 * hi + 96 - 59);
        float tv0[16], tv1[16];
#pragma unroll
        for (int r = 0; r < 16; ++r) { const int cr = (r & 3) + 8 * (r >> 2); tv0[r] = tb[59 - cr]; tv1[r] = tb[27 - cr]; }
        __builtin_amdgcn_sched_barrier(0);
#pragma unroll
        for (int r = 0; r < 16; ++r) { p0[r] += tv0[r]; p1[r] += tv1[r]; }
      }
      softmax_pv_tr<4>(p0, p1, mst, lst, o, kt + 16384, va0, va1);
    }
    slot = slot == 2 ? 0 : slot + 1;
  }
#undef A_DMA
  const float ltot = lst + __shfl_xor(lst, 32);
  const float inv = 1.f / ltot;
  u32x2 gpre[4][4];
  if (m == 0) {
#pragma unroll
    for (int je = 0; je < 4; ++je)
#pragma unroll
      for (int g4 = 0; g4 < 4; ++g4) gpre[je][g4] = *(const u32x2*)(P + (rowbase + qrow) * LDP + PA_G + h * 128 + 32 * je + 8 * g4 + 4 * hi);
  }
  __syncthreads();
  LAS float* ex = (LAS float*)lds + rg * 4096;
  if (m == 1) {
#pragma unroll
    for (int je = 0; je < 4; ++je)
#pragma unroll
      for (int r = 0; r < 16; ++r) ex[(je * 16 + r) * 64 + lane] = o[je][r] * inv;
  }
  __syncthreads();
  if (m == 0) {
    float ssq = 0.f;
#pragma unroll
    for (int je = 0; je < 4; ++je)
#pragma unroll
      for (int r = 0; r < 16; ++r) { const float a = o[je][r] * inv - lam * ex[(je * 16 + r) * 64 + lane]; o[je][r] = a; ssq += a * a; }
    ssq += __shfl_xor(ssq, 32);
    const float rn = rsqrtf(ssq * (1.f / 128.f) + EPS) * (1.f - lam_init);
    const size_t row = rowbase + qrow;
#pragma unroll
    for (int je = 0; je < 4; ++je)
#pragma unroll
      for (int g4 = 0; g4 < 4; ++g4) {
        const int e0 = 32 * je + 8 * g4 + 4 * hi;
        const f32x4 w4 = *(const f32x4*)(subln_w + e0);
        const u32x2 gw = gpre[je][g4];
        const float v0 = o[je][4 * g4 + 0] * rn * w4[0] * silu_fast(bflo(gw.x)), v1 = o[je][4 * g4 + 1] * rn * w4[1] * silu_fast(bfhi(gw.x));
        const float v2 = o[je][4 * g4 + 2] * rn * w4[2] * silu_fast(bflo(gw.y)), v3 = o[je][4 * g4 + 3] * rn * w4[3] * silu_fast(bfhi(gw.y));
        u32x2 ov; ov.x = cvtpk(v0, v1); ov.y = cvtpk(v2, v3);
        *(u32x2*)(BR + row * LDBR + h * 128 + e0) = ov;
      }
  }
  __builtin_amdgcn_s_setprio(0);
}

constexpr int B_IMG = 256 * 256, B_BTAB = B_IMG;
__device__ __forceinline__ void unit_B(LAS unsigned char* lds, const bf16_t* __restrict__ P, const float* __restrict__ rel_bias, const float* __restrict__ sinks,
                                       bf16_t* __restrict__ BR, const int unit) {
  const int tid = launder((int)threadIdx.x), lane = tid & 63, wave = __builtin_amdgcn_readfirstlane(tid >> 6), r32 = lane & 31, hi = lane >> 5;
  const int b = unit >> 6, kv = (unit >> 4) & 3, qb = unit & 15;
  const size_t rowbase = (size_t)b * S;
  LAS float* btab = (LAS float*)(lds + B_BTAB);
  btab[tid] = rel_bias[t5_bucket_fast(tid & 127) * 24 + 8 + kv * 4 + (tid >> 7)] * LOG2E;
  {
    const int kk = tid >> 1, half = tid & 1, pos = 128 * (qb - 1) + kk;
    if (pos >= 0) {
      const bf16_t* kg = P + (rowbase + pos) * LDP + PB_K + kv * 64 + half * 32;
      const bf16_t* vg = P + (rowbase + pos) * LDP + PB_V + kv * 64 + half * 32;
      u32x4 kr[4], vr[4];
#pragma unroll
      for (int i = 0; i < 4; ++i) { kr[i] = *(const u32x4*)(kg + 8 * i); vr[i] = *(const u32x4*)(vg + 8 * i); }
#pragma unroll
      for (int i = 0; i < 4; ++i) { *(LAS u32x4*)(lds + off_b(kk, 4 * half + i)) = kr[i]; *(LAS u32x4*)(lds + off_b(kk, 8 + 4 * half + i)) = vr[i]; }
    }
  }
  __syncthreads();
  const int g = wave >> 1, hb = kv * 4 + g;
  const float sink2 = sinks[hb] * LOG2E;
  const LaneB LB = lane_b(lane);
  unsigned ko[4], va0[2], va1[2];
#pragma unroll
  for (int d0 = 0; d0 < 4; ++d0) ko[d0] = 256u * r32 + 16u * ((unsigned)(2 * d0 + hi) ^ LB.xr);
#pragma unroll
  for (int je = 0; je < 2; ++je) { va0[je] = LB.T0 + 64u * ((unsigned)(2 + je) ^ LB.q); va1[je] = LB.T1 + 64u * ((unsigned)(2 + je) ^ LB.q); }
#pragma unroll 1
  for (int rgi = 0; rgi < 2; ++rgi) {
    const int rr = 32 * (2 * (wave & 1) + rgi);
    const int qrow = 128 * qb + rr + r32;
    bf16x8 qf[4];
    load_qf(qf, P + (rowbase + qrow) * LDP + PB_Q + hb * 64 + 8 * hi);
    float mst = sink2, lst = (hi == 0) ? 1.f : 0.f;
    f32x16 o[2];
#pragma unroll
    for (int je = 0; je < 2; ++je)
#pragma unroll
      for (int r = 0; r < 16; ++r) o[je][r] = 0.f;
    const int jlo = (rr + 1) >> 6, jhi = (rr + 159) >> 6;
    for (int j = jlo; j <= jhi; ++j) {
      if (qb == 0 && j < 2) continue;
      f32x16 p0, p1;
      st_tile_b(p0, p1, lds + 256 * 64 * j, ko, qf, 0.f);
#pragma unroll
      for (int r = 0; r < 16; ++r) {
        const int d0 = 128 + rr + r32 - (64 * j + crow(r, hi)), d1 = d0 - 32;
        const float t0 = btab[g * 128 + min(max(d0, 0), 127)], t1 = btab[g * 128 + min(max(d1, 0), 127)];
        p0[r] = (d0 >= 0 && d0 < 128) ? p0[r] + t0 : -INFINITY;
        p1[r] = (d1 >= 0 && d1 < 128) ? p1[r] + t1 : -INFINITY;
      }
      softmax_pv_tr<2>(p0, p1, mst, lst, o, lds + 256 * 64 * j, va0, va1);
    }
    const float ltot = lst + __shfl_xor(lst, 32);
    const float inv = 1.f / ltot;
    const size_t row = rowbase + qrow;
#pragma unroll
    for (int je = 0; je < 2; ++je)
#pragma unroll
      for (int g4 = 0; g4 < 4; ++g4) {
        const int e0 = 32 * je + 8 * g4 + 4 * hi;
        const u32x2 gw = *(const u32x2*)(P + row * LDP + PB_G + hb * 64 + e0);
        const float v0 = o[je][4 * g4 + 0] * inv * silu_fast(bflo(gw.x)), v1 = o[je][4 * g4 + 1] * inv * silu_fast(bfhi(gw.x));
        const float v2 = o[je][4 * g4 + 2] * inv * silu_fast(bflo(gw.y)), v3 = o[je][4 * g4 + 3] * inv * silu_fast(bfhi(gw.y));
        u32x2 ov; ov.x = cvtpk(v0, v1); ov.y = cvtpk(v2, v3);
        *(u32x2*)(BR + row * LDBR + 1024 + hb * 64 + e0) = ov;
      }
  }
}

__device__ __forceinline__ float silu2_fast(float y, float g) { return (y * g) * __builtin_amdgcn_rcpf((1.f + ex2(-LOG2E * y)) * (1.f + ex2(-LOG2E * g))); }
__device__ __forceinline__ void unit_D(LAS unsigned char* lds, const bf16_t* __restrict__ P, const float* __restrict__ cw, const float* __restrict__ cb,
                                       const float* __restrict__ lnw, const float* __restrict__ lnb, bf16_t* __restrict__ BR, const int unit) {
  const int tid = launder((int)threadIdx.x), lane = tid & 63, wave = __builtin_amdgcn_readfirstlane(tid >> 6);
  const int t0 = unit * 32, tl0 = t0 & (S - 1), c = 2 * tid;
  typedef float f32x2 __attribute__((ext_vector_type(2)));
#pragma unroll
  for (int r = 0; r < 8; ++r) {
    const int i = wave + 8 * r;
    if (i < 62) {
      LAS unsigned char* d = lds + i * 2048;
      if (tl0 - 30 + i >= 0) { const bf16_t* gp = P + (size_t)(t0 - 30 + i) * LDP + P_GLU + 8 * lane; glds16(gp, d); glds16(gp + 512, d + 1024); }
      else { *(LAS u32x4*)(d + 16 * lane) = (u32x4){0u, 0u, 0u, 0u}; *(LAS u32x4*)(d + 1024 + 16 * lane) = (u32x4){0u, 0u, 0u, 0u}; }
    }
  }
  f32x2 w[31];
#pragma unroll
  for (int k = 0; k < 31; ++k) w[k] = *(const f32x2*)(cw + k * 1024 + c);
  const f32x2 bias = *(const f32x2*)(cb + c);
  u32x2 gw[4][4];
#pragma unroll
  for (int jj = 0; jj < 4; ++jj)
#pragma unroll
    for (int i = 0; i < 4; ++i) gw[jj][i] = *(const u32x2*)(P + (size_t)(t0 + 4 * wave + jj) * LDP + P_DG + 4 * lane + 256 * i);
  __builtin_amdgcn_sched_barrier(0);
  asm volatile("s_waitcnt vmcnt(0) lgkmcnt(0)" ::: "memory");
  __syncthreads();
  f32x2 acc[32];
#pragma unroll
  for (int j = 0; j < 32; ++j) acc[j] = bias;
  const LAS unsigned char* up = lds + 4 * tid;
#pragma unroll
  for (int ib = 0; ib < 8; ++ib) {
    unsigned vv[8];
#pragma unroll
    for (int ii = 0; ii < 8; ++ii) { const int i = 8 * ib + ii; if (i < 62) vv[ii] = *(const LAS unsigned*)(up + i * 2048); }
#pragma unroll
    for (int ii = 0; ii < 8; ++ii) { const int i = 8 * ib + ii; if (i < 62) {
      f32x2 u; u.x = bflo(vv[ii]); u.y = bfhi(vv[ii]);
#pragma unroll
      for (int j = 0; j < 32; ++j) { const int k = i - j; if (k >= 0 && k <= 30) acc[j] = acc[j] + w[k] * u; } } }
  }
  __syncthreads();
  LAS float* cs = (LAS float*)lds;
#pragma unroll
  for (int j = 0; j < 32; ++j) *(LAS f32x2*)(cs + j * 1024 + c) = acc[j];
  f32x4 lw[4], lb[4];
#pragma unroll
  for (int i = 0; i < 4; ++i) { lw[i] = *(const f32x4*)(lnw + 4 * lane + 256 * i); lb[i] = *(const f32x4*)(lnb + 4 * lane + 256 * i); }
  __syncthreads();
#pragma unroll
  for (int jj = 0; jj < 4; ++jj) {
    const int j = 4 * wave + jj; const size_t row = (size_t)t0 + j;
    f32x4 v[4]; float s = 0.f;
#pragma unroll
    for (int i = 0; i < 4; ++i) { v[i] = *(const LAS f32x4*)(cs + j * 1024 + 4 * lane + 256 * i); s += (v[i][0] + v[i][1]) + (v[i][2] + v[i][3]); }
    const float mean = wave_sum(s) * (1.f / 1024.f);
    float q = 0.f;
#pragma unroll
    for (int i = 0; i < 4; ++i) { v[i] = v[i] - mean; q += (v[i][0] * v[i][0] + v[i][1] * v[i][1]) + (v[i][2] * v[i][2] + v[i][3] * v[i][3]); }
    const float rstd = rsqrtf(wave_sum(q) * (1.f / 1024.f) + EPS);
#pragma unroll
    for (int i = 0; i < 4; ++i) {
      const int cc = 4 * lane + 256 * i;
      const u32x2 g2 = gw[jj][i];
      const f32x4 y = v[i] * rstd * lw[i] + lb[i];
      u32x2 ov; ov.x = cvtpk(silu2_fast(y[0], bflo(g2.x)), silu2_fast(y[1], bfhi(g2.x)));
      ov.y = cvtpk(silu2_fast(y[2], bflo(g2.y)), silu2_fast(y[3], bfhi(g2.y)));
      *(u32x2*)(BR + row * LDBR + 3072 + cc) = ov;
    }
  }
}

__device__ __forceinline__ void unit_premix32(LAS unsigned char* lds, const bf16_t* __restrict__ P, const float* __restrict__ cw, const float* __restrict__ cb, bf16_t* __restrict__ CONV,
                                              const bf16_t* __restrict__ Hb, const bf16_t* __restrict__ WdtT, const float* __restrict__ dt_bias, const float* __restrict__ a_log,
                                              float* __restrict__ DTA, const int unit) {
  const int tid = launder((int)threadIdx.x), lane = tid & 63, wave = __builtin_amdgcn_readfirstlane(tid >> 6);
  const size_t t0 = (size_t)unit * 32;
  typedef float f32x2 __attribute__((ext_vector_type(2)));
  const int c4 = (tid < 384 ? tid : 0) * 4;
  u32x2 raw[2][19];
  if (tid < 384) {
#pragma unroll
    for (int q = 0; q < 2; ++q) {
      const int tq = (int)t0 + 16 * q, tl0 = tq & (S - 1);
#pragma unroll
      for (int i = 0; i < 19; ++i) {
        if (tl0 - 3 + i >= 0) raw[q][i] = *(const u32x2*)(P + (size_t)(tq - 3 + i) * LDP + P_XBC + c4);
        else raw[q][i] = (u32x2){0u, 0u};
      }
    }
  }
  __builtin_amdgcn_sched_barrier(0);
  f32x4 acc[2];
  acc[0] = (f32x4){0.f, 0.f, 0.f, 0.f}; acc[1] = (f32x4){0.f, 0.f, 0.f, 0.f};
  {
    const bf16_t* ap = Hb + (t0 + (lane & 15)) * D + 256 * wave + 8 * (lane >> 4);
    const bf16_t* bp = WdtT + (size_t)(lane & 15) * D + 256 * wave + 8 * (lane >> 4);
    bf16x8 bfr[8], afr[2][8];
#pragma unroll
    for (int ks = 0; ks < 8; ++ks) { bfr[ks] = *(const bf16x8*)(bp + 32 * ks); afr[0][ks] = *(const bf16x8*)(ap + 32 * ks); afr[1][ks] = *(const bf16x8*)(ap + (size_t)16 * D + 32 * ks); }
#pragma unroll
    for (int ks = 0; ks < 8; ++ks) { acc[0] = __builtin_amdgcn_mfma_f32_16x16x32_bf16(afr[0][ks], bfr[ks], acc[0], 0, 0, 0); acc[1] = __builtin_amdgcn_mfma_f32_16x16x32_bf16(afr[1][ks], bfr[ks], acc[1], 0, 0, 0); }
  }
  LAS float* part = (LAS float*)lds;
  LAS float* dS = (LAS float*)(lds + 16384);
  LAS float* xS = (LAS float*)(lds + 16384 + 2048);
  __syncthreads();
#pragma unroll
  for (int rt = 0; rt < 2; ++rt)
#pragma unroll
    for (int r = 0; r < 4; ++r) part[(wave * 32 + 16 * rt + 4 * (lane >> 4) + r) * 16 + (lane & 15)] = acc[rt][r];
  __syncthreads();
  { const int row = tid >> 4, h = tid & 15;
    float sum = 0.f;
#pragma unroll
    for (int w = 0; w < 8; ++w) sum += part[(w * 32 + row) * 16 + h];
    const float a = -ex2(a_log[h] * LOG2E), v = sum + dt_bias[h];
    const float d = fmaxf(v, 0.f) + 0.6931471805599453f * __builtin_amdgcn_logf(1.f + ex2(-LOG2E * fabsf(v)));
    dS[h * 32 + row] = d; xS[h * 32 + row] = d * a; }
  __syncthreads();
  { const int h = 2 * wave + (lane >> 5), row = lane & 31;
    const float d = dS[h * 32 + row]; float sc = xS[h * 32 + row];
#pragma unroll
    for (int o = 1; o < 32; o <<= 1) { const float t = __shfl_up(sc, o, 32); if (row >= o) sc += t; }
    *(f32x2*)(DTA + ((t0 + row) * 16 + h) * 2) = (f32x2){d, sc}; }
  if (tid < 384) {
    f32x4 w[4];
#pragma unroll
    for (int k = 0; k < 4; ++k) w[k] = *(const f32x4*)(cw + k * 1536 + c4);
    const f32x4 bias = *(const f32x4*)(cb + c4);
#pragma unroll
    for (int q = 0; q < 2; ++q) {
      f32x4 r0 = (f32x4){bflo(raw[q][0].x), bfhi(raw[q][0].x), bflo(raw[q][0].y), bfhi(raw[q][0].y)};
      f32x4 r1 = (f32x4){bflo(raw[q][1].x), bfhi(raw[q][1].x), bflo(raw[q][1].y), bfhi(raw[q][1].y)};
      f32x4 r2 = (f32x4){bflo(raw[q][2].x), bfhi(raw[q][2].x), bflo(raw[q][2].y), bfhi(raw[q][2].y)};
#pragma unroll
      for (int j = 0; j < 16; ++j) {
        const f32x4 r3 = (f32x4){bflo(raw[q][j + 3].x), bfhi(raw[q][j + 3].x), bflo(raw[q][j + 3].y), bfhi(raw[q][j + 3].y)};
        const f32x4 v = bias + w[0] * r0 + w[1] * r1 + w[2] * r2 + w[3] * r3;
        u32x2 o; o.x = cvtpk(silu_fast(v[0]), silu_fast(v[1])); o.y = cvtpk(silu_fast(v[2]), silu_fast(v[3]));
        *(u32x2*)(CONV + (t0 + 16 * q + j) * 1536 + c4) = o;
        r0 = r1; r1 = r2; r2 = r3;
      }
    }
  }
}
constexpr int C_ST = 272;
constexpr int C_CM = 0, C_BM = 128 * C_ST, C_BMT = 2 * 128 * C_ST, C_XT = 3 * 128 * C_ST, C_HS = C_XT + 64 * C_ST, C_AC = C_HS + 64 * C_ST, C_DTS = C_AC + 512, C_SSS = C_DTS + 512, C_END = C_SSS + 1024;
__device__ __forceinline__ void unit_C(LAS unsigned char* lds, const bf16_t* __restrict__ P, const bf16_t* __restrict__ CONV, const float* __restrict__ DTA, const float* __restrict__ dskip,
                                       bf16_t* __restrict__ BR, float* __restrict__ SS, const int unit) {
  const int tid = launder((int)threadIdx.x), lane = tid & 63, wave = __builtin_amdgcn_readfirstlane(tid >> 6), r32 = lane & 31, hi = lane >> 5;
  const int b = unit >> 4, h = unit & 15, g = h >> 3;
  const float dsk = dskip[h];
  const int hf = wave >> 2, lg = hf ? 3 - (wave & 3) : (wave & 3), pt = wave & 1, nt = wave >> 1;
  const int l_lane = 32 * lg + r32;
  typedef float f32x2 __attribute__((ext_vector_type(2)));
  f32x16 hst;
#pragma unroll
  for (int r = 0; r < 16; ++r) hst[r] = 0.f;
  u32x4 cmr[4], bmr[4], xsr[2]; f32x2 dab[4], dax[2]; float actot_r, cb1_r, cb2_r, cb3_r;
  const int prow = tid & 31, pch = tid >> 5, xrow = tid & 63, xch = tid >> 6;
  LAS float* acS = (LAS float*)(lds + C_AC); LAS float* dtS = (LAS float*)(lds + C_DTS); LAS float* ssS = (LAS float*)(lds + C_SSS);
#define C_LOAD(c_) do { const size_t t0_ = (size_t)b * S + 128 * (c_); \
    _Pragma("unroll") for (int i = 0; i < 4; ++i) { const size_t r_ = t0_ + prow + 32 * i; cmr[i] = *(const u32x4*)(CONV + r_ * 1536 + 1280 + g * 128 + pch * 8); \
      bmr[i] = *(const u32x4*)(CONV + r_ * 1536 + 1024 + g * 128 + pch * 8); dab[i] = *(const f32x2*)(DTA + (r_ * 16 + h) * 2); } \
    _Pragma("unroll") for (int i = 0; i < 2; ++i) { const size_t r_ = t0_ + xrow + 64 * i; xsr[i] = *(const u32x4*)(CONV + r_ * 1536 + h * 64 + xch * 8); dax[i] = *(const f32x2*)(DTA + (r_ * 16 + h) * 2); } \
    cb1_r = DTA[((t0_ + 31) * 16 + h) * 2 + 1]; cb2_r = DTA[((t0_ + 63) * 16 + h) * 2 + 1]; cb3_r = DTA[((t0_ + 95) * 16 + h) * 2 + 1]; actot_r = DTA[((t0_ + 127) * 16 + h) * 2 + 1]; } while (0)
  C_LOAD(0);
#pragma unroll 1
  for (int c = 0; c < 16; ++c) {
    const size_t t0 = (size_t)b * S + 128 * c;
    { const float o1 = cb1_r, o2 = o1 + cb2_r, o3 = o2 + cb3_r; dab[1].y += o1; dab[2].y += o2; dab[3].y += o3; actot_r += o3; }
#pragma unroll
    for (int i = 0; i < 4; ++i) {
      const int row = prow + 32 * i;
      *(LAS u32x4*)(lds + C_CM + row * C_ST + pch * 16) = cmr[i];
      *(LAS u32x4*)(lds + C_BM + row * C_ST + pch * 16) = bmr[i];
      const float ds = ex2((actot_r - dab[i].y) * LOG2E);
      LAS unsigned short* bt = (LAS unsigned short*)(lds + C_BMT + (pch * 8) * C_ST + row * 2);
      const unsigned q0 = cvtpk(bflo(bmr[i].x) * ds, bfhi(bmr[i].x) * ds), q1 = cvtpk(bflo(bmr[i].y) * ds, bfhi(bmr[i].y) * ds);
      const unsigned q2 = cvtpk(bflo(bmr[i].z) * ds, bfhi(bmr[i].z) * ds), q3 = cvtpk(bflo(bmr[i].w) * ds, bfhi(bmr[i].w) * ds);
      bt[0 * (C_ST / 2)] = (unsigned short)(q0 & 0xffffu); bt[1 * (C_ST / 2)] = (unsigned short)(q0 >> 16); bt[2 * (C_ST / 2)] = (unsigned short)(q1 & 0xffffu); bt[3 * (C_ST / 2)] = (unsigned short)(q1 >> 16);
      bt[4 * (C_ST / 2)] = (unsigned short)(q2 & 0xffffu); bt[5 * (C_ST / 2)] = (unsigned short)(q2 >> 16); bt[6 * (C_ST / 2)] = (unsigned short)(q3 & 0xffffu); bt[7 * (C_ST / 2)] = (unsigned short)(q3 >> 16);
    }
#pragma unroll
    for (int i = 0; i < 2; ++i) {
      const int row = xrow + 64 * i; const float dtv = dax[i].x;
      LAS unsigned short* xt = (LAS unsigned short*)(lds + C_XT + (xch * 8) * C_ST + row * 2);
      const unsigned q0 = cvtpk(bflo(xsr[i].x) * dtv, bfhi(xsr[i].x) * dtv), q1 = cvtpk(bflo(xsr[i].y) * dtv, bfhi(xsr[i].y) * dtv);
      const unsigned q2 = cvtpk(bflo(xsr[i].z) * dtv, bfhi(xsr[i].z) * dtv), q3 = cvtpk(bflo(xsr[i].w) * dtv, bfhi(xsr[i].w) * dtv);
      xt[0 * (C_ST / 2)] = (unsigned short)(q0 & 0xffffu); xt[1 * (C_ST / 2)] = (unsigned short)(q0 >> 16); xt[2 * (C_ST / 2)] = (unsigned short)(q1 & 0xffffu); xt[3 * (C_ST / 2)] = (unsigned short)(q1 >> 16);
      xt[4 * (C_ST / 2)] = (unsigned short)(q2 & 0xffffu); xt[5 * (C_ST / 2)] = (unsigned short)(q2 >> 16); xt[6 * (C_ST / 2)] = (unsigned short)(q3 & 0xffffu); xt[7 * (C_ST / 2)] = (unsigned short)(q3 >> 16);
    }
    if (pch == 0) {
#pragma unroll
      for (int i = 0; i < 4; ++i) { acS[prow + 32 * i] = dab[i].y; dtS[prow + 32 * i] = dab[i].x; }
    }
    if (c > 0) {
#pragma unroll
      for (int r = 0; r < 16; ++r) *(LAS unsigned short*)(lds + C_HS + (32 * pt + crow(r, hi)) * C_ST + (32 * nt + r32) * 2) = (unsigned short)f2bf(hst[r]);
    }
    const float actot = actot_r;
    __syncthreads();
    u32x2 zw4[4];
#pragma unroll
    for (int g4 = 0; g4 < 4; ++g4) zw4[g4] = *(const u32x2*)(P + (t0 + l_lane) * LDP + P_Z + h * 64 + 32 * hf + 8 * g4 + 4 * hi);
    if (c + 1 < 16) C_LOAD(c + 1);
    const LAS unsigned char* cmb = lds + C_CM + l_lane * C_ST + 16 * hi;
    bf16x8 cf[8];
#pragma unroll
    for (int ks = 0; ks < 8; ++ks) cf[ks] = *(const LAS bf16x8*)(cmb + ks * 32);
    f32x16 yo;
#pragma unroll
    for (int r = 0; r < 16; ++r) yo[r] = 0.f;
    if (c > 0) {
      const LAS unsigned char* hb_ = lds + C_HS + (32 * hf + r32) * C_ST + 16 * hi;
#pragma unroll
      for (int kh = 0; kh < 2; ++kh) {
        bf16x8 ha[4];
#pragma unroll
        for (int ks = 0; ks < 4; ++ks) ha[ks] = *(const LAS bf16x8*)(hb_ + (4 * kh + ks) * 32);
        __builtin_amdgcn_sched_barrier(0);
#pragma unroll
        for (int ks = 0; ks < 4; ++ks) yo = __builtin_amdgcn_mfma_f32_32x32x16_bf16(ha[ks], cf[4 * kh + ks], yo, 0, 0, 0);
      }
    }
    f32x16 yd[1];
#pragma unroll
    for (int r = 0; r < 16; ++r) yd[0][r] = 0.f;
    const float al = acS[l_lane];
#pragma unroll 1
    for (int st = 0; st <= lg; ++st) {
      f32x16 sa;
#pragma unroll
      for (int r = 0; r < 16; ++r) sa[r] = 0.f;
      const LAS unsigned char* bb_ = lds + C_BM + (32 * st + r32) * C_ST + 16 * hi;
#pragma unroll
      for (int kh = 0; kh < 2; ++kh) {
        bf16x8 ba[4];
#pragma unroll
        for (int ks = 0; ks < 4; ++ks) ba[ks] = *(const LAS bf16x8*)(bb_ + (4 * kh + ks) * 32);
        __builtin_amdgcn_sched_barrier(0);
#pragma unroll
        for (int ks = 0; ks < 4; ++ks) sa = __builtin_amdgcn_mfma_f32_32x32x16_bf16(ba[ks], cf[4 * kh + ks], sa, 0, 0, 0);
      }
#pragma unroll
      for (int r = 0; r < 16; ++r) { const int si = 32 * st + crow(r, hi); const float dec = ex2((al - acS[si]) * LOG2E); sa[r] = (si <= l_lane) ? sa[r] * dec : 0.f; }
      const LAS unsigned char* xb_ = lds + C_XT + (32 * hf + r32) * C_ST + (32 * st) * 2 + 8 * hi;
      pv_step<1>(yd, pack8<0>(sa), xb_, C_ST);
      pv_step<1>(yd, pack8<1>(sa), xb_ + 32, C_ST);
    }
    {
      const float cdec = ex2(actot * LOG2E);
      hst = hst * cdec;
      const LAS unsigned char* xa_ = lds + C_XT + (32 * pt + r32) * C_ST + 16 * hi; const LAS unsigned char* bt_ = lds + C_BMT + (32 * nt + r32) * C_ST + 16 * hi;
#pragma unroll
      for (int kh = 0; kh < 4; ++kh) {
        bf16x8 fa[2], fb[2];
#pragma unroll
        for (int ks = 0; ks < 2; ++ks) { fa[ks] = *(const LAS bf16x8*)(xa_ + (2 * kh + ks) * 32); fb[ks] = *(const LAS bf16x8*)(bt_ + (2 * kh + ks) * 32); }
        __builtin_amdgcn_sched_barrier(0);
#pragma unroll
        for (int ks = 0; ks < 2; ++ks) hst = __builtin_amdgcn_mfma_f32_32x32x16_bf16(fa[ks], fb[ks], hst, 0, 0, 0);
      }
    }
    {
      const float el = ex2(al * LOG2E), dl = dsk / dtS[l_lane];
      const size_t row = t0 + l_lane;
      float ssq = 0.f;
#pragma unroll
      for (int g4 = 0; g4 < 4; ++g4) {
        const int p0_ = 32 * hf + 8 * g4 + 4 * hi;
        const u32x2 zw = zw4[g4];
        float yv[4];
#pragma unroll
        for (int i = 0; i < 4; ++i) { const float xdt = bf2f(*(const LAS unsigned short*)(lds + C_XT + (p0_ + i) * C_ST + l_lane * 2)); yv[i] = yd[0][4 * g4 + i] + el * yo[4 * g4 + i] + dl * xdt; }
        const float y0 = yv[0] * silu_fast(bflo(zw.x)), y1 = yv[1] * silu_fast(bfhi(zw.x)), y2 = yv[2] * silu_fast(bflo(zw.y)), y3 = yv[3] * silu_fast(bfhi(zw.y));
        ssq += (y0 * y0 + y1 * y1) + (y2 * y2 + y3 * y3);
        u32x2 ov; ov.x = cvtpk(y0, y1); ov.y = cvtpk(y2, y3);
        *(u32x2*)(BR + row * LDBR + 2048 + h * 64 + p0_) = ov;
      }
      ssq += __shfl_xor(ssq, 32);
      if (hi == 0) ssS[hf * 128 + l_lane] = ssq;
    }
    __syncthreads();
    if (tid < 128) SS[(t0 + tid) * 16 + h] = ssS[tid] + ssS[128 + tid];
  }
#undef C_LOAD
}

#define XB_TMO      128
#define XB_XCNT(j)  (256  + 64 * (j))
#define XB_XSUB(j)  (1280 + 64 * (j))
#define XB_XGEN(j)  (2304 + 64 * (j))
#define XB_TOP      3328
#define XB_TOPGEN   3392
#define XCD_BAR_WORDS 3456
#define XB_SPIN_CAP (1u << 18)
__device__ __forceinline__ unsigned xb_ld(unsigned* p)              { return __hip_atomic_load(p, __ATOMIC_RELAXED, __HIP_MEMORY_SCOPE_AGENT); }
__device__ __forceinline__ unsigned xb_add(unsigned* p, unsigned v) { return __hip_atomic_fetch_add(p, v, __ATOMIC_RELAXED, __HIP_MEMORY_SCOPE_AGENT); }
__device__ __forceinline__ unsigned xb_xcc_id() { return (unsigned)__builtin_amdgcn_s_getreg((3 << 11) | 20) & 0xFu; }
#define XB_SPIN(cond, bar) do { unsigned _sp = 0; while (cond) { __builtin_amdgcn_s_sleep(1); \
    if ((++_sp & 255u) == 0u) { if (xb_ld(&(bar)[XB_TMO])) break; if (_sp > XB_SPIN_CAP) { atomicAdd(&(bar)[XB_TMO], 1u); break; } } } } while (0)
struct XcdBarrier { unsigned* bar; unsigned x; volatile LAS unsigned* st; };
__device__ __forceinline__ XcdBarrier xcd_barrier_post(unsigned* bar, volatile LAS unsigned* st) {
    XcdBarrier b; b.bar = bar; b.x = xb_xcc_id(); b.st = st;
    if (threadIdx.x == 0) (void)xb_add(&bar[XB_XCNT(b.x)], 1u);
    return b;
}
__device__ __forceinline__ void xcd_barrier_complete(unsigned* bar, unsigned x, unsigned& nloc, unsigned& nx) {
    const unsigned G = gridDim.x * gridDim.y * gridDim.z;
    unsigned sum, cnt, mine, sp = 0u;
    for (;;) {
        sum = 0u; cnt = 0u; mine = 0u;
#pragma unroll 1
        for (unsigned j = 0; j < 16; ++j) { const unsigned c = xb_ld(&bar[XB_XCNT(j)]); sum += c; cnt += (c > 0u) ? 1u : 0u; mine = (j == x) ? c : mine; }
        if (sum == G) break;
        __builtin_amdgcn_s_sleep(1);
        if ((++sp & 255u) == 0u) { if (xb_ld(&bar[XB_TMO])) break; if (sp > XB_SPIN_CAP) { atomicAdd(&bar[XB_TMO], 1u); break; } }
    }
    nloc = mine > 0u ? mine : 1u; nx = cnt > 0u ? cnt : 1u;
}
__device__ __forceinline__ void xcd_barrier(const XcdBarrier& b) {
    asm volatile("s_waitcnt vmcnt(0)" ::: "memory");
    __syncthreads();
    if (threadIdx.x == 0) {
        unsigned* bar = b.bar;
        asm volatile("" : "+s"(bar));
        __builtin_amdgcn_s_waitcnt(0);
        unsigned nloc = b.st[0], nx = b.st[1];
        if (nloc == 0u) { xcd_barrier_complete(bar, b.x, nloc, nx); b.st[0] = nloc; b.st[1] = nx; }
        const unsigned old = xb_add(&bar[XB_XSUB(b.x)], 1u);
        const unsigned gen = old / nloc;
        if (old + 1u == (gen + 1u) * nloc) {
            __builtin_amdgcn_fence(__ATOMIC_RELEASE, "agent");
            asm volatile("s_waitcnt vmcnt(0)" ::: "memory");
            const unsigned og = xb_add(&bar[XB_TOP], 1u);
            const unsigned tg = og / nx;
            if (og + 1u == (tg + 1u) * nx) xb_add(&bar[XB_TOPGEN], 1u);
            else XB_SPIN(xb_ld(&bar[XB_TOPGEN]) == tg, bar);
            __builtin_amdgcn_fence(__ATOMIC_ACQUIRE, "agent");
            xb_add(&bar[XB_XGEN(b.x)], 1u);
            asm volatile("s_waitcnt vmcnt(0)" ::: "memory");
        } else {
            XB_SPIN(xb_ld(&bar[XB_XGEN(b.x)]) == gen, bar);
            __builtin_amdgcn_fence(__ATOMIC_ACQUIRE, "agent");
            asm volatile("s_waitcnt vmcnt(0)" ::: "memory");
        }
    }
    __syncthreads();
}

__global__ void __launch_bounds__(NTHREADS, 2) mega(Args args) {
  extern __shared__ __attribute__((aligned(16))) unsigned char lds_raw[];
  LAS unsigned char* lds = (LAS unsigned char*)lds_raw;
  cg::grid_group grid = cg::this_grid();
  const int G = gridDim.x, bx = blockIdx.x;
#define LANE() (launder((int)threadIdx.x) & 63)
#define GW() (bx * NWAVES + __builtin_amdgcn_readfirstlane(launder((int)threadIdx.x) >> 6))
  const int NGW = G * NWAVES;
  unsigned char* ws = args.ws;
  const float* x = args.in[0];
  const float* norm_w = args.in[1];
  const float* w_in = args.in[2];
  const float* ssd_norm_w = args.in[11];
  const float* w_branch = args.in[16];
  const float* w_out = args.in[17];
  const float* final_norm_w = args.in[19];
  bf16_t* WinT = (bf16_t*)(ws + WS_WIN); bf16_t* WbrT = (bf16_t*)(ws + WS_WBR); bf16_t* WoutT = (bf16_t*)(ws + WS_WOUT);
  bf16_t* Hb = (bf16_t*)(ws + WS_H); bf16_t* PROJ = (bf16_t*)(ws + WS_PROJ); float* DT = (float*)(ws + WS_DT);
  bf16_t* BR = (bf16_t*)(ws + WS_BR); float* SS = (float*)(ws + WS_SS); float* MACC = (float*)(ws + WS_MACC); bf16_t* MERGED = (bf16_t*)(ws + WS_MERGED);
  float* X1 = (float*)(ws + WS_X1); float* X2 = (float*)(ws + WS_X2);
  const int lo = args.ph_lo, hi = args.ph_hi;
  if (threadIdx.x < 16) ((volatile LAS unsigned*)(lds + LDS_BYTES - 64))[threadIdx.x] = 0u;
  __syncthreads();
  const XcdBarrier xbar = xcd_barrier_post((unsigned*)(ws + WS_CTL) + 1024, (volatile LAS unsigned*)(lds + LDS_BYTES - 32));
#define IN(k) (lo <= (k) && (k) < hi)
  if (lo < 0) grid.sync();
#define SEAM(k) do { if (IN(k) && IN((k) + 1)) xcd_barrier(xbar); } while (0)

  if (IN(PH_CONV)) {
    constexpr int I_IN = 32 * (NPAD / 32), I_BR = 64 * (D / 32), I_OUT = 32 * (D / 32), I_L = I_IN + I_BR + I_OUT;
    const int lane = LANE(); const int gw = GW();
    for (int rep = 0; rep < REP_CONVW; ++rep)
    for (int it = gw; it < 2 * I_L; it += NGW) {
      const int l = it / I_L; int r = it % I_L;
      if (r < I_IN) { conv_item(w_in + (size_t)l * D * NIN, NIN, D, WinT + (size_t)l * NPAD * D, 0, nullptr, r, NPAD / 32, lane); continue; } r -= I_IN;
      if (r < I_BR) { conv_item(w_branch + (size_t)l * 4096 * D, D, 4096, WbrT + (size_t)l * D * 4096, 2, ssd_norm_w + l * 1024, r, D / 32, lane); continue; } r -= I_BR;
      conv_item(w_out + (size_t)l * D * D, D, D, WoutT + (size_t)l * D * D, 1, nullptr, r, D / 32, lane);
    }
  }
  if (IN(PH_CONV)) {
    const int gt = bx * NTHREADS + launder((int)threadIdx.x);
    if (gt < 2 * D) {
      const int l = gt / D, k = gt % D; const float* src = w_in + (size_t)l * D * NIN + (size_t)k * NIN + 8192;
      bf16_t* dst = (bf16_t*)(ws + WS_WDT) + (size_t)l * 16 * D + k;
#pragma unroll
      for (int q = 0; q < 4; ++q) { const f32x4 v = *(const f32x4*)(src + 4 * q); dst[(4 * q + 0) * D] = (bf16_t)f2bf(v[0]); dst[(4 * q + 1) * D] = (bf16_t)f2bf(v[1]); dst[(4 * q + 2) * D] = (bf16_t)f2bf(v[2]); dst[(4 * q + 3) * D] = (bf16_t)f2bf(v[3]); }
    }
  }
  if (IN(PH_CONV)) { const int lane = LANE(); const int gw = GW(); for (int m = gw; m < T; m += NGW) norm_row_bf16(x + (size_t)m * D, norm_w, Hb + (size_t)m * D, lane); }
  SEAM(PH_CONV);
#pragma unroll 1
  for (int l = 0; l < 2; ++l) {
    const int pb = PH_L0 + l * PH_PER_LAYER;
    const float* xin = (l == 0) ? x : X1; float* xout = (l == 0) ? X1 : X2;
    if (IN(pb + 0) && l > 0) { const int lane = LANE(); const int gw = GW(); for (int m = gw; m < T; m += NGW) norm_row_bf16(xin + (size_t)m * D, norm_w + (size_t)l * D, Hb + (size_t)m * D, lane); }
    if (l > 0) SEAM(pb + 0);
    if (IN(pb + 1)) {
      SchedInproj Sd{(const char*)Hb, (const char*)(WinT + (size_t)l * NPAD * D), G, bx};
      EpiProj E{PROJ, ws + WS_G8};
      for (int rep = 0; rep < REP_INPROJ; ++rep) pg8::gemm_phase(lds, D, D, Sd, E);
    }
    SEAM(pb + 1);
    if (IN(pb + 2) && FAST_C) {
      for (int rep = 0; rep < REP_PREMIX; ++rep)
      for (int u = bx; u < 256; u += G)
        unit_premix32(lds, PROJ, args.in[6] + (size_t)l * 4 * 1536, args.in[7] + l * 1536, (bf16_t*)(ws + WS_CONV), Hb, (const bf16_t*)(ws + WS_WDT) + (size_t)l * 16 * D,
                      args.in[8] + l * 16, args.in[9] + l * 16, (float*)(ws + WS_DTA), u);
    }
    SEAM(pb + 2);
    if (IN(pb + 3)) {
      constexpr int NU_C = FAST_C ? 64 : 0, NU_A = FAST_A ? 512 : 0, NU_B = FAST_B ? 256 : 0, NU_D = FAST_D ? 256 : 0;
      const float lam_init = (l == 0) ? 0.2f : (float)(0.8 - 0.6 * 0.7408182206817179);
      float lam;
      { const float* dl = args.in[3] + l * 256; float s1 = 0.f, s2 = 0.f;
        for (int j = 0; j < 64; ++j) { s1 = fmaf(dl[j], dl[64 + j], s1); s2 = fmaf(dl[128 + j], dl[192 + j], s2); }
        lam = ex2(s1 * LOG2E) - ex2(s2 * LOG2E) + lam_init; }
      volatile LAS int* slot = (volatile LAS int*)(lds + LDS_BYTES - 64);
      for (int rep = 0; rep < REP_MIX; ++rep) {
      unsigned* ctr = (unsigned*)(ws + WS_CTL) + 64 * (1 + l + 2 * rep);
      for (;;) {
        __syncthreads();
        if (threadIdx.x == 0) *slot = (int)atomicAdd(ctr, 1u);
        __syncthreads();
        int u = *slot;
        if (u >= NU_C + NU_A + NU_B + NU_D) break;
        if (u < NU_C) { unit_C(lds, PROJ, (const bf16_t*)(ws + WS_CONV), (const float*)(ws + WS_DTA), args.in[10] + l * 16, BR, SS, u); continue; } u -= NU_C;
        const int grp = u >> 2, k = u & 3;
        if (k < 2) { unit_A(lds, PROJ, args.in[18], args.in[4] + l * 128, lam, lam_init, BR, 2 * grp + k); continue; }
        if (k == 2) { unit_B(lds, PROJ, args.in[18], args.in[5] + l * 16, BR, grp); continue; }
        unit_D(lds, PROJ, args.in[12] + (size_t)l * 31 * 1024, args.in[13] + l * 1024, args.in[14] + l * 1024, args.in[15] + l * 1024, BR, grp);
      }
      }
    }
    SEAM(pb + 3);
    if (IN(pb + 4)) {
      SchedMergeMP Sd{(const char*)BR, (const char*)(WbrT + (size_t)l * D * 4096), G, bx};
      EpiMergeMP E{ws + WS_G8, SS, MERGED};
      for (int rep = 0; rep < REP_MERGE; ++rep) pg8::gemm_phase(lds, LDBR, 4096, Sd, E);
    }
    SEAM(pb + 4);
    if (IN(pb + 5)) {
      SchedOut Sd{(const char*)MERGED, (const char*)(WoutT + (size_t)l * D * D), G, bx};
      EpiOut E{xin, xout};
      for (int rep = 0; rep < REP_OUT; ++rep) pg8::gemm_phase(lds, D, D, Sd, E);
    }
    SEAM(pb + 5);
  }
  if (IN(PH_FINAL)) { const int lane = LANE(); const int gw = GW(); for (int m = gw; m < T; m += NGW) norm_row_f32(X2 + (size_t)m * D, final_norm_w, args.out + (size_t)m * D, lane); }
#undef IN
#undef SEAM
}
}

extern "C" void kernel_launch(void* const* d_in, const int* in_sizes, int n_in, void* d_out, int out_size, void* d_ws, size_t ws_size, hipStream_t stream) {
  static int grid = 0;
  if (grid == 0) {
    int dev = 0, cus = 0, per_cu = 0;
    hipGetDevice(&dev);
    hipDeviceGetAttribute(&cus, hipDeviceAttributeMultiprocessorCount, dev);
    hipFuncSetAttribute((const void*)mega, hipFuncAttributeMaxDynamicSharedMemorySize, LDS_BYTES);
    hipOccupancyMaxActiveBlocksPerMultiprocessor(&per_cu, (const void*)mega, NTHREADS, LDS_BYTES);
    if (per_cu < 1) per_cu = 1;
    grid = cus * per_cu;
    if (ws_size < WS_END) fprintf(stderr, "kernel_launch: workspace too small: %zu < %zu\n", ws_size, (size_t)WS_END);
  }
  unsigned char* ws = (unsigned char*)d_ws;

  Args a{};
  for (int i = 0; i < 20; ++i) a.in[i] = (const float*)d_in[i];
  a.out = (float*)d_out; a.ws = ws;
  auto launch = [&](int lo, int hi) {
    a.ph_lo = lo; a.ph_hi = hi;
    void* kargs[] = {&a};
    hipError_t e = hipLaunchCooperativeKernel((const void*)mega, dim3(grid), dim3(NTHREADS), kargs, LDS_BYTES, stream);
    if (e != hipSuccess) fprintf(stderr, "cooperative launch failed: %s (grid %d)\n", hipGetErrorString(e), grid);
  };
  hipMemsetAsync(ws + WS_CTL, 0, 32768, stream);
  launch(0, PH_COUNT);
}
```

```cpp
#include <hip/hip_runtime.h>
#include <hip/hip_cooperative_groups.h>
#include <math.h>
#include <stdint.h>
#include <stdio.h>
namespace cg = cooperative_groups;

namespace {
constexpr int NB = 4, S = 2048, D = 2048, T = NB * S, NIN = 20496;
constexpr float EPS = 1e-6f;
constexpr int LDP = 20480;
constexpr int PA_Q = 0, PA_K = 1024, PA_V = 2048, PA_G = 3072, PB_Q = 4096, PB_K = 5120, PB_V = 5376, PB_G = 5632,
              P_XBC = 6656, P_Z = 8192, P_GLU = 9216, P_DG = 11264, P_MG = 12288;
__host__ __device__ __forceinline__ int np_of_t8(int t8) { return t8 < 32 ? P_MG + 256 * t8 : t8 < 36 ? PA_G + 256 * (t8 - 32) : t8 < 40 ? PB_G + 256 * (t8 - 36) : t8 < 44 ? P_Z + 256 * (t8 - 40) : P_DG + 256 * (t8 - 44); }
__host__ __device__ __forceinline__ int pn_of_j(int j) { return j < 12 ? j : j < 18 ? j + 4 : j < 24 ? j + 8 : j + 12; }
constexpr int N8 = 48 * 256;
constexpr int NPAD = 20480;
constexpr int LDBR = 4096;

typedef unsigned short bf16_t;
#define LAS __attribute__((address_space(3)))
#define GAS __attribute__((address_space(1)))
typedef short bf16x8 __attribute__((ext_vector_type(8)));
typedef float f32x4 __attribute__((ext_vector_type(4)));
typedef unsigned u32x4 __attribute__((ext_vector_type(4)));
typedef unsigned u32x2 __attribute__((ext_vector_type(2)));
typedef int i32x4 __attribute__((ext_vector_type(4)));

__device__ __forceinline__ int launder(int v) { asm volatile("" : "+v"(v)); return v; }
__device__ __forceinline__ float bf2f(bf16_t v) { return __uint_as_float((unsigned)v << 16); }
__device__ __forceinline__ float bflo(unsigned w) { return __uint_as_float(w << 16); }
__device__ __forceinline__ float bfhi(unsigned w) { return __uint_as_float(w & 0xffff0000u); }
__device__ __forceinline__ unsigned f2bf(float f) { unsigned u = __float_as_uint(f); return (u + 0x7fffu + ((u >> 16) & 1u)) >> 16; }
__device__ __forceinline__ unsigned pk2(float lo, float hi) { return f2bf(lo) | (f2bf(hi) << 16); }
__device__ __forceinline__ float sigm(float x) { return 1.f / (1.f + expf(-x)); }
__device__ __forceinline__ float sigm_fast(float x) { return __builtin_amdgcn_rcpf(1.f + __builtin_amdgcn_exp2f(-1.4426950408889634f * x)); }
__device__ __forceinline__ float silu(float x) { return x / (1.f + expf(-x)); }
__device__ __forceinline__ float wave_sum(float v) {
#pragma unroll
  for (int o = 1; o < 64; o <<= 1) v += __shfl_xor(v, o);
  return v;
}
__device__ __forceinline__ float wave_max(float v) {
#pragma unroll
  for (int o = 1; o < 64; o <<= 1) v = fmaxf(v, __shfl_xor(v, o));
  return v;
}
__device__ __forceinline__ int t5_bucket(int n) {
  if (n < 16) return n;
  float v = logf((float)n / 16.f) / logf(8.f) * 16.f;
  int l = 16 + (int)v;
  return l < 31 ? l : 31;
}

namespace pg8 {
constexpr int BM = 256, BK = 64, HALF = 128, HTB = HALF * BK * 2, STAGE_BYTES = 8 * HTB, NXCD = 8, WGM = 8;
__host__ __device__ __forceinline__ int lds_byte(int r, int c) { const int st = (r >> 4) * 2 + (c >> 5), rr = r & 15, cc = c & 31, ob = rr * 64 + cc * 2; return st * 1024 + (ob ^ (((ob >> 9) & 1) << 5)); }
__host__ __device__ __forceinline__ void stage_rc(int b, int& R, int& C) { const int st = b / 1024, sb = b % 1024, swz = sb ^ (((sb >> 9) & 1) << 5); R = (st >> 1) * 16 + swz / 64; C = (st & 1) * 32 + (swz % 64) / 2; }
__host__ __device__ __forceinline__ int perm32(int rho) { const int n = rho >> 4, i = rho & 15; return 8 * (i >> 2) + 4 * n + (i & 3); }

struct Unit { int pm, pn, aux, nt; const char* A; const char* B; };

__device__ __forceinline__ void tile_of(int L, int nM, int nN, int& pm, int& pn) {
  const int nwg = nM * nN;
  int wgid = L; { const int q = nwg / NXCD, r = nwg % NXCD, xcd = wgid % NXCD, off = wgid / NXCD; wgid = (xcd < r ? xcd * (q + 1) : r * (q + 1) + (xcd - r) * q) + off; }
  const int nig = WGM * nN, gid = wgid / nig, fm = gid * WGM, gsz = (nM - fm) < WGM ? (nM - fm) : WGM;
  pm = fm + ((wgid % nig) % gsz); pn = (wgid % nig) / gsz;
}

__device__ __forceinline__ unsigned cvt_pk_bf16(float lo, float hi) { unsigned r; asm volatile("v_cvt_pk_bf16_f32 %0, %1, %2" : "=v"(r) : "v"(lo), "v"(hi)); return r; }

template <bool I8>
__device__ __forceinline__ f32x4 mma16(const bf16x8 a, const bf16x8 b, const f32x4 c) {
  if constexpr (I8) return __builtin_bit_cast(f32x4, __builtin_amdgcn_mfma_i32_16x16x64_i8(__builtin_bit_cast(i32x4, a), __builtin_bit_cast(i32x4, b), __builtin_bit_cast(i32x4, c), 0, 0, 0));
  else return __builtin_amdgcn_mfma_f32_16x16x32_bf16(a, b, c, 0, 0, 0);
}
template <class Epi, class Sched>
__device__ __forceinline__ void gemm_phase(LAS unsigned char* lds, const int lda, const int ldb, const Sched& S, const Epi& E) {
    const int tid = launder((int)threadIdx.x), wid = __builtin_amdgcn_readfirstlane(tid >> 6), lane = tid & 63, wr = wid >> 2, wc = wid & 3, fr = lane & 15, fq = lane >> 4;
    unsigned voffA[2], voffB[2];
#pragma unroll
    for (int i = 0; i < 2; ++i) { int R, C; stage_rc(tid * 16 + i * 8192, R, C); const int Rb = Epi::PERM ? ((R & ~31) + perm32(R & 31)) : R;
        voffA[i] = (unsigned)(R * lda + C) * 2u; voffB[i] = (unsigned)(Rb * ldb + C) * 2u; }
    const size_t kstep = (size_t)(BK * 2);
    const size_t hstepA = (size_t)HALF * lda * 2, hstepB = (size_t)HALF * ldb * 2;
    const unsigned ldsw = (unsigned)wid * 1024u;
    const int aoff = lds_byte(wr * 64 + fr, fq * 8), boff = lds_byte(wc * 32 + fr, fq * 8);
#define PG8_SA(b, h) (((b) * 2 + (h)) * HTB)
#define PG8_SB(b, h) ((4 + (b) * 2 + (h)) * HTB)
#define PG8_STAGE(bufoff, gbase, voff) do { _Pragma("unroll") for (int _i = 0; _i < 2; ++_i) \
        __builtin_amdgcn_global_load_lds((const unsigned*)((const char*)(gbase) + (voff)[_i]), (LAS unsigned*)(lds + (bufoff) + ldsw + _i * 8192), 16, 0, 0); } while (0)
#define PG8_LDA(dst, b, h) do { _Pragma("unroll") for (int m = 0; m < 4; ++m) _Pragma("unroll") for (int k = 0; k < 2; ++k) dst[m][k] = *(const LAS bf16x8*)(lds + PG8_SA(b, h) + aoff + m * 2048 + k * 1024); } while (0)
#define PG8_LDB(dst, b, h) do { _Pragma("unroll") for (int n = 0; n < 2; ++n) _Pragma("unroll") for (int k = 0; k < 2; ++k) dst[n][k] = *(const LAS bf16x8*)(lds + PG8_SB(b, h) + boff + n * 2048 + k * 1024); } while (0)
#define PG8_MMA(ai, bj, At, Bt) do { __builtin_amdgcn_s_setprio(1); _Pragma("unroll") for (int m = 0; m < 4; ++m) _Pragma("unroll") for (int n = 0; n < 2; ++n) _Pragma("unroll") for (int k = 0; k < 2; ++k) \
        acc[ai][bj][m][n] = mma16<Epi::I8>(Bt[n][k], At[m][k], acc[ai][bj][m][n]); __builtin_amdgcn_s_setprio(0); } while (0)
#define PG8_WAIT_V(n) asm volatile("s_waitcnt vmcnt(" #n ")" ::: "memory")
#define PG8_WAIT_L(n) asm volatile("s_waitcnt lgkmcnt(" #n ")" ::: "memory")
#define PG8_BAR __builtin_amdgcn_s_barrier()
#define PG8_SCHED __builtin_amdgcn_sched_barrier(0)
    Unit cur, nxt; int ui = 0;
    if (!S.next(0, cur)) return;
    f32x4 acc[2][2][4][2];
#pragma unroll
    for (int a = 0; a < 2; ++a)
#pragma unroll
        for (int b = 0; b < 2; ++b)
#pragma unroll
            for (int m = 0; m < 4; ++m)
#pragma unroll
                for (int n = 0; n < 2; ++n) acc[a][b][m][n] = (f32x4){0.f, 0.f, 0.f, 0.f};
    bf16x8 At[4][2], B0[2][2], B1[2][2];
    const char* cA = cur.A; const char* cB = cur.B;
    PG8_SCHED; PG8_STAGE(PG8_SB(0, 0), cB, voffB); PG8_SCHED; PG8_STAGE(PG8_SB(0, 1), cB + hstepB, voffB); PG8_SCHED; PG8_STAGE(PG8_SA(0, 0), cA, voffA); PG8_SCHED; PG8_STAGE(PG8_SA(0, 1), cA + hstepA, voffA); PG8_SCHED;
    if (wr == 1) PG8_BAR;
    PG8_WAIT_V(2); PG8_BAR;
    PG8_SCHED; PG8_STAGE(PG8_SB(1, 0), cB + kstep, voffB); PG8_SCHED; PG8_STAGE(PG8_SA(1, 0), cA + kstep, voffA); PG8_SCHED; PG8_STAGE(PG8_SB(1, 1), cB + hstepB + kstep, voffB); PG8_SCHED;
    PG8_WAIT_V(6); PG8_BAR;
    for (;;) {
        const bool has_next = S.next(ui + 1, nxt);
        const char* nA = has_next ? nxt.A : cA; const char* nB = has_next ? nxt.B : cB;
        const int nt = cur.nt;
        for (int t = 0; t < nt; t += 2) {
            const bool last = (t == nt - 2);
            const char* a1 = cA + (size_t)(t + 1) * kstep;
            const char* a2 = last ? nA : cA + (size_t)(t + 2) * kstep; const char* b2 = last ? nB : cB + (size_t)(t + 2) * kstep;
            const char* a3 = a2 + kstep; const char* b3 = b2 + kstep;
            PG8_LDB(B0, 0, 0); PG8_LDB(B1, 0, 1); PG8_SCHED; PG8_LDA(At, 0, 0); PG8_STAGE(PG8_SA(1, 1), a1 + hstepA, voffA);
            PG8_WAIT_V(8); PG8_WAIT_L(0); PG8_BAR; PG8_MMA(0, 0, At, B0); PG8_MMA(0, 1, At, B1); PG8_BAR; PG8_SCHED;
            PG8_LDA(At, 0, 1); PG8_STAGE(PG8_SB(0, 0), b2, voffB); PG8_STAGE(PG8_SB(0, 1), b2 + hstepB, voffB); PG8_STAGE(PG8_SA(0, 0), a2, voffA);
            PG8_WAIT_V(8); PG8_WAIT_L(0); PG8_BAR; PG8_MMA(1, 0, At, B0); PG8_MMA(1, 1, At, B1); PG8_BAR; PG8_SCHED;
            PG8_LDB(B0, 1, 0); PG8_LDB(B1, 1, 1); PG8_SCHED; PG8_LDA(At, 1, 0); PG8_STAGE(PG8_SA(0, 1), a2 + hstepA, voffA);
            PG8_WAIT_V(8); PG8_WAIT_L(0); PG8_BAR; PG8_MMA(0, 0, At, B0); PG8_MMA(0, 1, At, B1); PG8_BAR; PG8_SCHED;
            PG8_LDA(At, 1, 1); PG8_STAGE(PG8_SB(1, 0), b3, voffB); PG8_STAGE(PG8_SB(1, 1), b3 + hstepB, voffB); PG8_STAGE(PG8_SA(1, 0), a3, voffA);
            PG8_WAIT_V(8); PG8_WAIT_L(0); PG8_BAR; PG8_MMA(1, 0, At, B0); PG8_MMA(1, 1, At, B1); PG8_BAR; PG8_SCHED;
        }
        if (wr == 0) PG8_BAR;
        E(acc, cur, wr, wc, fr, fq);
        if (!has_next) break;
        if (!Epi::KEEP || cur.aux == 4) {
#pragma unroll
        for (int a = 0; a < 2; ++a)
#pragma unroll
            for (int b = 0; b < 2; ++b)
#pragma unroll
                for (int m = 0; m < 4; ++m)
#pragma unroll
                    for (int n = 0; n < 2; ++n) acc[a][b][m][n] = (f32x4){0.f, 0.f, 0.f, 0.f};
        }
        cur = nxt; cA = nA; cB = nB; ++ui;
        if (wr == 1) PG8_BAR;
    }
    PG8_WAIT_V(0);
    PG8_BAR;
#undef PG8_SA
#undef PG8_SB
#undef PG8_STAGE
#undef PG8_LDA
#undef PG8_LDB
#undef PG8_MMA
#undef PG8_WAIT_V
#undef PG8_WAIT_L
#undef PG8_BAR
#undef PG8_SCHED
}

template <class Epi, class Sched>
__device__ __forceinline__ void gemm_phase_hm(LAS unsigned char* lds, const int lda, const int ldb, const Sched& S, const Epi& E) {
    const int tid = launder((int)threadIdx.x), wid = __builtin_amdgcn_readfirstlane(tid >> 6), lane = tid & 63, wr = wid >> 2, wc = wid & 3, fr = lane & 15, fq = lane >> 4;
    unsigned voffA[2], voffB[2];
#pragma unroll
    for (int i = 0; i < 2; ++i) { int R, C; stage_rc(tid * 16 + i * 8192, R, C); const int Rb = Epi::PERM ? ((R & ~31) + perm32(R & 31)) : R;
        voffA[i] = (unsigned)(R * lda + C) * 2u; voffB[i] = (unsigned)(Rb * ldb + C) * 2u; }
    const size_t kstep = (size_t)(BK * 2);
    const size_t hstepB = (size_t)HALF * ldb * 2;
    const unsigned ldsw = (unsigned)wid * 1024u;
    const int aoff = lds_byte(wr * 64 + fr, fq * 8), boff = lds_byte(wc * 32 + fr, fq * 8);
    constexpr int SETB = 3 * HTB;
#define HM_STAGE(dst, gbase, voff) do { _Pragma("unroll") for (int _i = 0; _i < 2; ++_i) \
        __builtin_amdgcn_global_load_lds((const unsigned*)((const char*)(gbase) + (voff)[_i]), (LAS unsigned*)(lds + (dst) + ldsw + _i * 8192), 16, 0, 0); } while (0)
#define HM_STAGE_TILE(setoff, pa, pb) do { HM_STAGE((setoff), (pb), voffB); HM_STAGE((setoff) + HTB, (pb) + hstepB, voffB); HM_STAGE((setoff) + 2 * HTB, (pa), voffA); } while (0)
#define HM_WAIT_V(n) asm volatile("s_waitcnt vmcnt(" #n ")" ::: "memory")
#define HM_WAIT_L(n) asm volatile("s_waitcnt lgkmcnt(" #n ")" ::: "memory")
#define HM_BAR __builtin_amdgcn_s_barrier()
#define HM_SCHED __builtin_amdgcn_sched_barrier(0)
    Unit cur, nxt; int ui = 0;
    if (!S.next(0, cur)) return;
    f32x4 acc[2][4][2], tot[2][4][2];
#pragma unroll
    for (int b = 0; b < 2; ++b)
#pragma unroll
        for (int m = 0; m < 4; ++m)
#pragma unroll
            for (int n = 0; n < 2; ++n) { acc[b][m][n] = (f32x4){0.f, 0.f, 0.f, 0.f}; tot[b][m][n] = (f32x4){0.f, 0.f, 0.f, 0.f}; }
    bf16x8 At[4][2], B0[2][2], B1[2][2];
    const char* cA = cur.A; const char* cB = cur.B;
    HM_SCHED; HM_STAGE_TILE(0, cA, cB); HM_SCHED; HM_STAGE_TILE(SETB, cA + kstep, cB + kstep); HM_SCHED;
    if (wr == 1) HM_BAR;
    HM_WAIT_V(6); HM_BAR; HM_BAR;
    int cs = 0;
    for (;;) {
        const bool has_next = S.next(ui + 1, nxt);
        const char* nA = has_next ? nxt.A : cA; const char* nB = has_next ? nxt.B : cB;
        const int nt = cur.nt;
#pragma unroll 1
        for (int t = 0; t < nt; ++t) {
            const int t2 = t + 2;
            const char* a2 = (t2 < nt) ? cA + (size_t)t2 * kstep : nA + (size_t)(t2 - nt) * kstep;
            const char* b2 = (t2 < nt) ? cB + (size_t)t2 * kstep : nB + (size_t)(t2 - nt) * kstep;
            const int so = cs * SETB, ss = (cs == 0 ? 2 : cs - 1) * SETB;
            const LAS unsigned char* pb_ = lds + so + boff; const LAS unsigned char* pa_ = lds + so + 2 * HTB + aoff;
#pragma unroll
            for (int n = 0; n < 2; ++n)
#pragma unroll
                for (int k = 0; k < 2; ++k) { B0[n][k] = *(const LAS bf16x8*)(pb_ + n * 2048 + k * 1024); B1[n][k] = *(const LAS bf16x8*)(pb_ + HTB + n * 2048 + k * 1024); }
            HM_SCHED;
#pragma unroll
            for (int m = 0; m < 4; ++m)
#pragma unroll
                for (int k = 0; k < 2; ++k) At[m][k] = *(const LAS bf16x8*)(pa_ + m * 2048 + k * 1024);
            HM_STAGE_TILE(ss, a2, b2);
            HM_WAIT_V(6); HM_WAIT_L(0); HM_BAR;
            __builtin_amdgcn_s_setprio(1);
#pragma unroll
            for (int m = 0; m < 4; ++m)
#pragma unroll
                for (int n = 0; n < 2; ++n)
#pragma unroll
                    for (int k = 0; k < 2; ++k) acc[0][m][n] = __builtin_amdgcn_mfma_f32_16x16x32_bf16(B0[n][k], At[m][k], acc[0][m][n], 0, 0, 0);
#pragma unroll
            for (int m = 0; m < 4; ++m)
#pragma unroll
                for (int n = 0; n < 2; ++n)
#pragma unroll
                    for (int k = 0; k < 2; ++k) acc[1][m][n] = __builtin_amdgcn_mfma_f32_16x16x32_bf16(B1[n][k], At[m][k], acc[1][m][n], 0, 0, 0);
            __builtin_amdgcn_s_setprio(0);
            HM_BAR; HM_SCHED;
            cs = (cs == 2) ? 0 : cs + 1;
        }
        if (wr == 0) HM_BAR;
        E(acc, tot, cur, wr, wc, fr, fq);
        if (!has_next) break;
#pragma unroll
        for (int b = 0; b < 2; ++b)
#pragma unroll
            for (int m = 0; m < 4; ++m)
#pragma unroll
                for (int n = 0; n < 2; ++n) acc[b][m][n] = (f32x4){0.f, 0.f, 0.f, 0.f};
        cur = nxt; cA = nA; cB = nB; ++ui;
        if (wr == 1) HM_BAR;
    }
    HM_WAIT_V(0);
    HM_BAR;
#undef HM_STAGE
#undef HM_STAGE_TILE
#undef HM_WAIT_V
#undef HM_WAIT_L
#undef HM_BAR
#undef HM_SCHED
}
}

constexpr size_t AL(size_t x) { return (x + 255) & ~(size_t)255; }
constexpr size_t WS_CTL = 0, CTL_BYTES = 1u << 20;
constexpr size_t WS_WIN = WS_CTL + CTL_BYTES;
constexpr size_t WS_WBR = WS_WIN + AL((size_t)2 * NPAD * D * 2);
constexpr size_t WS_WOUT = WS_WBR + AL((size_t)2 * D * 4096 * 2);
constexpr size_t WS_WDT = WS_WOUT + AL((size_t)2 * D * D * 2);
constexpr size_t WS_H = WS_WDT + AL((size_t)2 * 16 * D * 2);
constexpr size_t WS_PROJ = WS_H + AL((size_t)T * D * 2);
constexpr size_t WS_DT = WS_PROJ + AL((size_t)T * LDP * 2);
constexpr size_t WS_BR = WS_DT + AL((size_t)T * 16 * 4);
constexpr size_t WS_SS = WS_BR + AL((size_t)T * LDBR * 2);
constexpr size_t WS_MACC = WS_SS + AL((size_t)T * 16 * 4);
constexpr size_t WS_MERGED = WS_MACC + AL((size_t)T * D * 4);
constexpr size_t WS_X1 = WS_MERGED + AL((size_t)T * D * 2);
constexpr size_t WS_X2 = WS_X1 + AL((size_t)T * D * 4);
constexpr size_t WS_CONV = WS_X2 + AL((size_t)T * D * 4);
constexpr size_t WS_DTS = WS_CONV + AL((size_t)T * 1536 * 4);
constexpr size_t WS_DTA = WS_DTS + AL((size_t)T * 16 * 4);
constexpr size_t WS_U = WS_DTA + AL((size_t)T * 32 * 4);
constexpr size_t WS_G8 = WS_U + AL((size_t)T * 1024 * 4);
constexpr size_t WS_H8 = WS_G8 + AL((size_t)T * 8192);
constexpr size_t WS_SH = WS_H8 + AL((size_t)T * D);
constexpr size_t WS_W8 = WS_SH + AL((size_t)T * 4);
constexpr size_t WS_SW = WS_W8 + AL((size_t)2 * N8 * D);
constexpr size_t WS_END = WS_SW + AL((size_t)2 * N8 * 4);

constexpr int NWAVES = 8, NTHREADS = 512;
constexpr int LDS_BYTES = 153088;

enum { PH_CONV = 0, PH_L0 = 1  , PH_PER_LAYER = 6, PH_FINAL = 13, PH_COUNT = 14 };

struct Args {
  const float* in[20];
  float* out;
  unsigned char* ws;
  int ph_lo, ph_hi;
};

__device__ __forceinline__ void conv_item(const float* __restrict__ W, int ldw, int K, bf16_t* __restrict__ WT, int mode, const float* __restrict__ kscale, int item, int nblk, int lane) {
  const int kb_i = item / nblk, nb = item % nblk, k0 = 64 * kb_i, n0 = 32 * nb;
  const int nq = lane & 7, kb = lane >> 3;
  const int np = n0 + 4 * nq;
  int nsrc = np; bool valid = true;
  if (mode == 0) { nsrc = (np < 8192) ? np : np + 16;
    if (np >= P_GLU && np < P_GLU + 2048) { const int c = np - P_GLU, k = c >> 8, cc = c & 255; nsrc = 9232 + ((cc < 128) ? (128 * k + cc) : (1024 + 128 * k + (cc - 128))); } }
  f32x4 v[8];
#pragma unroll
  for (int j = 0; j < 8; ++j) {
    const int k = k0 + 8 * kb + j;
    v[j] = valid ? __builtin_nontemporal_load((const f32x4*)(W + (size_t)k * ldw + nsrc)) : (f32x4){0.f, 0.f, 0.f, 0.f};
    if (mode == 2 && k >= 2048 && k < 3072) v[j] = v[j] * kscale[k - 2048];
  }
#pragma unroll
  for (int i = 0; i < 4; ++i) {
    u32x4 o; o.x = pk2(v[0][i], v[1][i]); o.y = pk2(v[2][i], v[3][i]); o.z = pk2(v[4][i], v[5][i]); o.w = pk2(v[6][i], v[7][i]);
    *(u32x4*)(WT + (size_t)(np + i) * K + k0 + 8 * kb) = o;
  }
}

__device__ __forceinline__ unsigned q8pack(float a, float b, float c, float d);
__device__ __forceinline__ void gate_w8_item(LAS unsigned char* lds, const float* __restrict__ W, signed char* __restrict__ W8l, float* __restrict__ SWl, int item) {
  const int tid = launder((int)threadIdx.x), lane = tid & 63, wave = __builtin_amdgcn_readfirstlane(tid >> 6);
  const int n0 = 32 * item, nq = lane & 7, kb = lane >> 3;
  const int np0 = np_of_t8(item >> 3) + 32 * (item & 7), ns0 = np0 < 8192 ? np0 : np0 + 16;
  const float* src = W + (size_t)(256 * wave + 8 * kb) * NIN + ns0 + 4 * nq;
  f32x4 v[4][8];
#pragma unroll
  for (int s = 0; s < 4; ++s)
#pragma unroll
    for (int j = 0; j < 8; ++j) v[s][j] = __builtin_nontemporal_load((const f32x4*)(src + (size_t)(64 * s + j) * NIN));
  f32x4 m4 = (f32x4){0.f, 0.f, 0.f, 0.f};
#pragma unroll
  for (int s = 0; s < 4; ++s)
#pragma unroll
    for (int j = 0; j < 8; ++j) { m4.x = fmaxf(m4.x, fabsf(v[s][j].x)); m4.y = fmaxf(m4.y, fabsf(v[s][j].y)); m4.z = fmaxf(m4.z, fabsf(v[s][j].z)); m4.w = fmaxf(m4.w, fabsf(v[s][j].w)); }
#pragma unroll
  for (int o = 8; o < 64; o <<= 1) { m4.x = fmaxf(m4.x, __shfl_xor(m4.x, o)); m4.y = fmaxf(m4.y, __shfl_xor(m4.y, o)); m4.z = fmaxf(m4.z, __shfl_xor(m4.z, o)); m4.w = fmaxf(m4.w, __shfl_xor(m4.w, o)); }
  LAS f32x4* pm = (LAS f32x4*)lds;
  __syncthreads();
  if (kb == 0) pm[wave * 8 + nq] = m4;
  __syncthreads();
  f32x4 cm = pm[nq];
#pragma unroll
  for (int w = 1; w < 8; ++w) { const f32x4 t = pm[w * 8 + nq]; cm.x = fmaxf(cm.x, t.x); cm.y = fmaxf(cm.y, t.y); cm.z = fmaxf(cm.z, t.z); cm.w = fmaxf(cm.w, t.w); }
  const f32x4 inv = (f32x4){cm.x > 0.f ? 127.f / cm.x : 0.f, cm.y > 0.f ? 127.f / cm.y : 0.f, cm.z > 0.f ? 127.f / cm.z : 0.f, cm.w > 0.f ? 127.f / cm.w : 0.f};
  if (wave == 0 && kb == 0) *(f32x4*)(SWl + n0 + 4 * nq) = cm * (1.f / 127.f);
#pragma unroll
  for (int i = 0; i < 4; ++i) {
    signed char* drow = W8l + (size_t)(n0 + 4 * nq + i) * D + 256 * wave + 8 * kb;
#pragma unroll
    for (int s = 0; s < 4; ++s) {
      u32x2 q; q.x = q8pack(v[s][0][i] * inv[i], v[s][1][i] * inv[i], v[s][2][i] * inv[i], v[s][3][i] * inv[i]); q.y = q8pack(v[s][4][i] * inv[i], v[s][5][i] * inv[i], v[s][6][i] * inv[i], v[s][7][i] * inv[i]);
      *(u32x2*)(drow + 64 * s) = q;
    }
  }
}
__device__ __forceinline__ unsigned q8pack(float a, float b, float c, float d) {
  return ((unsigned)(int)__builtin_rintf(a) & 0xffu) | (((unsigned)(int)__builtin_rintf(b) & 0xffu) << 8) | (((unsigned)(int)__builtin_rintf(c) & 0xffu) << 16) | ((unsigned)(int)__builtin_rintf(d) << 24);
}
__device__ __forceinline__ void norm_row_bf16(const float* __restrict__ xrow, const float* __restrict__ w, bf16_t* __restrict__ orow, signed char* __restrict__ qrow, float* __restrict__ qscale, int lane) {
  const f32x4* xr = (const f32x4*)xrow + lane; const f32x4* wr = (const f32x4*)w + lane;
  f32x4 v[8]; float s = 0.f;
#pragma unroll
  for (int j = 0; j < 8; ++j) { v[j] = xr[64 * j]; s += (v[j].x * v[j].x + v[j].y * v[j].y) + (v[j].z * v[j].z + v[j].w * v[j].w); }
  const float r = rsqrtf(wave_sum(s) * (1.f / D) + EPS);
  u32x2* o8 = (u32x2*)orow + lane;
  float am = 0.f;
#pragma unroll
  for (int j = 0; j < 8; ++j) { const f32x4 ww = wr[64 * j]; v[j] = (f32x4){v[j].x * r * ww.x, v[j].y * r * ww.y, v[j].z * r * ww.z, v[j].w * r * ww.w};
    u32x2 o; o.x = pk2(v[j].x, v[j].y); o.y = pk2(v[j].z, v[j].w); o8[64 * j] = o;
    am = fmaxf(fmaxf(am, fmaxf(fabsf(v[j].x), fabsf(v[j].y))), fmaxf(fabsf(v[j].z), fabsf(v[j].w))); }
  am = wave_max(am);
  const float inv = am > 0.f ? 127.f / am : 0.f;
  unsigned* q8 = (unsigned*)qrow + lane;
#pragma unroll
  for (int j = 0; j < 8; ++j) q8[64 * j] = q8pack(v[j].x * inv, v[j].y * inv, v[j].z * inv, v[j].w * inv);
  if (lane == 0) *qscale = am * (1.f / 127.f);
}
__device__ __forceinline__ void norm_row_bf16b(const bf16_t* __restrict__ xrow, const float* __restrict__ w, bf16_t* __restrict__ orow, signed char* __restrict__ qrow, float* __restrict__ qscale, int lane) {
  const u32x4* xr = (const u32x4*)xrow + lane; const f32x4* wr = (const f32x4*)w + 2 * lane;
  u32x4 v[4]; float s = 0.f;
#pragma unroll
  for (int j = 0; j < 4; ++j) { v[j] = xr[64 * j];
    const float a0 = bflo(v[j].x), a1 = bfhi(v[j].x), a2 = bflo(v[j].y), a3 = bfhi(v[j].y), a4 = bflo(v[j].z), a5 = bfhi(v[j].z), a6 = bflo(v[j].w), a7 = bfhi(v[j].w);
    s += ((a0 * a0 + a1 * a1) + (a2 * a2 + a3 * a3)) + ((a4 * a4 + a5 * a5) + (a6 * a6 + a7 * a7)); }
  const float r = rsqrtf(wave_sum(s) * (1.f / D) + EPS);
  u32x4* o8 = (u32x4*)orow + lane;
  f32x4 h[4][2]; float am = 0.f;
#pragma unroll
  for (int j = 0; j < 4; ++j) { const f32x4 w0 = wr[128 * j], w1 = wr[128 * j + 1]; u32x4 o;
    h[j][0] = (f32x4){bflo(v[j].x) * r * w0.x, bfhi(v[j].x) * r * w0.y, bflo(v[j].y) * r * w0.z, bfhi(v[j].y) * r * w0.w};
    h[j][1] = (f32x4){bflo(v[j].z) * r * w1.x, bfhi(v[j].z) * r * w1.y, bflo(v[j].w) * r * w1.z, bfhi(v[j].w) * r * w1.w};
    o.x = pk2(h[j][0].x, h[j][0].y); o.y = pk2(h[j][0].z, h[j][0].w); o.z = pk2(h[j][1].x, h[j][1].y); o.w = pk2(h[j][1].z, h[j][1].w); o8[64 * j] = o;
#pragma unroll
    for (int e = 0; e < 2; ++e) am = fmaxf(fmaxf(am, fmaxf(fabsf(h[j][e].x), fabsf(h[j][e].y))), fmaxf(fabsf(h[j][e].z), fabsf(h[j][e].w))); }
  am = wave_max(am);
  const float inv = am > 0.f ? 127.f / am : 0.f;
  u32x2* q8 = (u32x2*)qrow + lane;
#pragma unroll
  for (int j = 0; j < 4; ++j) { u32x2 q; q.x = q8pack(h[j][0].x * inv, h[j][0].y * inv, h[j][0].z * inv, h[j][0].w * inv); q.y = q8pack(h[j][1].x * inv, h[j][1].y * inv, h[j][1].z * inv, h[j][1].w * inv); q8[64 * j] = q; }
  if (lane == 0) *qscale = am * (1.f / 127.f);
}
__device__ __forceinline__ void norm_row_f32b(const bf16_t* __restrict__ xrow, const float* __restrict__ w, float* __restrict__ orow, int lane) {
  const u32x4* xr = (const u32x4*)xrow + lane; const f32x4* wr = (const f32x4*)w + 2 * lane;
  u32x4 v[4]; float s = 0.f;
#pragma unroll
  for (int j = 0; j < 4; ++j) { v[j] = xr[64 * j];
    const float a0 = bflo(v[j].x), a1 = bfhi(v[j].x), a2 = bflo(v[j].y), a3 = bfhi(v[j].y), a4 = bflo(v[j].z), a5 = bfhi(v[j].z), a6 = bflo(v[j].w), a7 = bfhi(v[j].w);
    s += ((a0 * a0 + a1 * a1) + (a2 * a2 + a3 * a3)) + ((a4 * a4 + a5 * a5) + (a6 * a6 + a7 * a7)); }
  const float r = rsqrtf(wave_sum(s) * (1.f / D) + EPS);
  f32x4* o = (f32x4*)orow + 2 * lane;
#pragma unroll
  for (int j = 0; j < 4; ++j) { const f32x4 w0 = wr[128 * j], w1 = wr[128 * j + 1];
    o[128 * j] = (f32x4){bflo(v[j].x) * r * w0.x, bfhi(v[j].x) * r * w0.y, bflo(v[j].y) * r * w0.z, bfhi(v[j].y) * r * w0.w};
    o[128 * j + 1] = (f32x4){bflo(v[j].z) * r * w1.x, bfhi(v[j].z) * r * w1.y, bflo(v[j].w) * r * w1.z, bfhi(v[j].w) * r * w1.w}; }
}
__device__ __forceinline__ void norm_row_f32(const float* __restrict__ xrow, const float* __restrict__ w, float* __restrict__ orow, int lane) {
  const f32x4* xr = (const f32x4*)xrow + lane; const f32x4* wr = (const f32x4*)w + lane;
  f32x4 v[8]; float s = 0.f;
#pragma unroll
  for (int j = 0; j < 8; ++j) { v[j] = xr[64 * j]; s += (v[j].x * v[j].x + v[j].y * v[j].y) + (v[j].z * v[j].z + v[j].w * v[j].w); }
  const float r = rsqrtf(wave_sum(s) * (1.f / D) + EPS);
  f32x4* o = (f32x4*)orow + lane;
#pragma unroll
  for (int j = 0; j < 8; ++j) { const f32x4 ww = wr[64 * j]; o[64 * j] = (f32x4){v[j].x * r * ww.x, v[j].y * r * ww.y, v[j].z * r * ww.z, v[j].w * r * ww.w}; }
}

struct SchedInproj {
  const char* A; const char* B; int G, c;
  __device__ __forceinline__ bool next(int i, pg8::Unit& u) const {
    const int L = i * G + c; if (L >= 32 * 32) return false;
    int j; pg8::tile_of(L, 32, 32, u.pm, j); u.pn = pn_of_j(j); u.aux = 0; u.nt = D / 64;
    u.A = A + (size_t)u.pm * 256 * D * 2; u.B = B + (size_t)u.pn * 256 * D * 2; return true;
  }
};
struct SchedGate8 {
  const char* A; const char* B; int G, c;
  __device__ __forceinline__ bool next(int i, pg8::Unit& u) const {
    const int L = i * G + c; if (L >= 32 * 48) return false;
    pg8::tile_of(L, 32, 48, u.pm, u.pn); u.aux = 0; u.nt = D / 128;
    u.A = A + (size_t)u.pm * 256 * D; u.B = B + (size_t)u.pn * 256 * D; return true;
  }
};
struct SchedMergeHM {
  const char* A; const char* B; int G, c;
  __device__ __forceinline__ bool next(int i, pg8::Unit& u) const {
    const int L = (i / 5) * G + c; if (L >= 64 * 8) return false;
    const int p = i % 5;
    int pm2, pn; pg8::tile_of(L >> 1, 32, 8, pm2, pn); u.pm = 2 * pm2 + (L & 1); u.pn = pn; u.aux = p;
    const int koff = (p == 0) ? 0 : (p == 1) ? 1024 : (p == 2) ? 2048 : (p == 3) ? 2560 : 3072;
    u.nt = (p == 2 || p == 3) ? 8 : 16;
    u.A = A + ((size_t)u.pm * 128 * LDBR + koff) * 2; u.B = B + ((size_t)u.pn * 256 * 4096 + koff) * 2; return true;
  }
};
struct EpiMergeHM {
  static constexpr bool PERM = true;
  const unsigned char* G8; const float* SS; bf16_t* MERGED;
  __device__ __forceinline__ void operator()(const f32x4 (&acc)[2][4][2], f32x4 (&tot)[2][4][2], const pg8::Unit& u, int wr, int wc, int fr_, int fq_) const {
    const int fr = launder(fr_), fq = launder(fq_);
    const int p = u.aux, bi = (p <= 2) ? p : p - 1;
    const int row0 = u.pm * 128 + wr * 64 + fr, col0 = u.pn * 256 + wc * 32 + 8 * fq;
    u32x2 gw[4][2];
#pragma unroll
    for (int m = 0; m < 4; ++m)
#pragma unroll
      for (int bj = 0; bj < 2; ++bj) gw[m][bj] = *(const u32x2*)(G8 + (size_t)(row0 + m * 16) * 8192 + bi * 2048 + col0 + bj * 128);
#pragma unroll
    for (int m = 0; m < 4; ++m) {
      const int row = row0 + m * 16;
      float rs = 1.f / 255.f;
      if (p == 2 || p == 3) { const f32x4 s0 = *(const f32x4*)(SS + (size_t)row * 16 + (p - 2) * 8), s1 = *(const f32x4*)(SS + (size_t)row * 16 + (p - 2) * 8 + 4);
        rs = rsqrtf(((s0[0] + s0[1]) + (s0[2] + s0[3]) + (s1[0] + s1[1]) + (s1[2] + s1[3])) * (1.f / 512.f) + EPS) * (1.f / 255.f); }
#pragma unroll
      for (int bj = 0; bj < 2; ++bj) {
        const u32x2 g = gw[m][bj];
        f32x4 v0 = acc[bj][m][0], v1 = acc[bj][m][1];
        v0[0] *= rs * (float)(g.x & 0xffu); v0[1] *= rs * (float)((g.x >> 8) & 0xffu); v0[2] *= rs * (float)((g.x >> 16) & 0xffu); v0[3] *= rs * (float)(g.x >> 24);
        v1[0] *= rs * (float)(g.y & 0xffu); v1[1] *= rs * (float)((g.y >> 8) & 0xffu); v1[2] *= rs * (float)((g.y >> 16) & 0xffu); v1[3] *= rs * (float)(g.y >> 24);
        v0 += tot[bj][m][0]; v1 += tot[bj][m][1];
        if (p < 4) { tot[bj][m][0] = v0; tot[bj][m][1] = v1; }
        else {
          u32x4 w; w.x = pg8::cvt_pk_bf16(v0[0], v0[1]); w.y = pg8::cvt_pk_bf16(v0[2], v0[3]); w.z = pg8::cvt_pk_bf16(v1[0], v1[1]); w.w = pg8::cvt_pk_bf16(v1[2], v1[3]);
          *(u32x4*)(MERGED + (size_t)row * D + col0 + bj * 128) = w;
          tot[bj][m][0] = (f32x4){0.f, 0.f, 0.f, 0.f}; tot[bj][m][1] = (f32x4){0.f, 0.f, 0.f, 0.f};
        }
      }
    }
  }
};
struct SchedMergeMP {
  const char* A; const char* B; int G, c;
  __device__ __forceinline__ bool next(int i, pg8::Unit& u) const {
    const int L = (i / 5) * G + c; if (L >= 32 * 8) return false;
    const int p = i % 5;
    pg8::tile_of(L, 32, 8, u.pm, u.pn); u.aux = p;
    const int koff = (p == 0) ? 0 : (p == 1) ? 1024 : (p == 2) ? 2048 : (p == 3) ? 2560 : 3072;
    u.nt = (p == 2 || p == 3) ? 8 : 16;
    u.A = A + ((size_t)u.pm * 256 * LDBR + koff) * 2; u.B = B + ((size_t)u.pn * 256 * 4096 + koff) * 2; return true;
  }
};
__device__ __forceinline__ float ub0(unsigned v) { return (float)(v & 0xffu); }
__device__ __forceinline__ float ub1(unsigned v) { return (float)((v >> 8) & 0xffu); }
__device__ __forceinline__ float ub2(unsigned v) { return (float)((v >> 16) & 0xffu); }
__device__ __forceinline__ float ub3(unsigned v) { return (float)(v >> 24); }
struct EpiMergeMP {
  static constexpr bool PERM = true, KEEP = true, I8 = false;
  const unsigned char* G8; const float* SS; bf16_t* MERGED; LAS float* rsl;
  __device__ __forceinline__ float rs_of(int row, int g) const {
    const f32x4 s0 = *(const f32x4*)(SS + (size_t)row * 16 + g * 8), s1 = *(const f32x4*)(SS + (size_t)row * 16 + g * 8 + 4);
    return rsqrtf(((s0[0] + s0[1]) + (s0[2] + s0[3]) + (s1[0] + s1[1]) + (s1[2] + s1[3])) * (1.f / 512.f) + EPS);
  }
  __device__ __forceinline__ void operator()(f32x4 (&acc)[2][2][4][2], const pg8::Unit& u, int wr, int wc, int fr_, int fq_) const {
    const int fr = launder(fr_), fq = launder(fq_);
    const int p = u.aux;
    const int row0 = u.pm * 256 + wr * 64 + fr, col0 = u.pn * 256 + wc * 32 + 8 * fq;
    const int pa = (p == 0) ? 0 : (p == 1) ? 1 : (p == 4) ? 3 : 2;
    if (p == 0) {
      const int t_ = (wr * 4 + wc) * 64 + fr + 16 * fq;
      if (t_ < 256) { const int row = u.pm * 256 + t_; rsl[2 * t_] = rs_of(row, 0); rsl[2 * t_ + 1] = rs_of(row, 1); }
    }
#pragma unroll
    for (int ai = 0; ai < 2; ++ai) {
      u32x2 ga[4][2], gb[4][2];
      if (p != 2) {
        const unsigned char* ba_ = G8 + ((size_t)((pa * 32 + u.pm) * 8 + u.pn) << 16) + (size_t)(((wr * 4 + wc) * 64 + fr + 16 * fq) * 16);
        const unsigned char* bb_ = G8 + ((size_t)(((p == 4 ? pa : pa + 1) * 32 + u.pm) * 8 + u.pn) << 16) + (size_t)(((wr * 4 + wc) * 64 + fr + 16 * fq) * 16);
#pragma unroll
        for (int m = 0; m < 4; ++m) {
          const u32x4 va = *(const u32x4*)(ba_ + (ai * 4 + m) * 8192), vb = *(const u32x4*)(bb_ + (ai * 4 + m) * 8192);
          ga[m][0] = (u32x2){va.x, va.y}; ga[m][1] = (u32x2){va.z, va.w}; gb[m][0] = (u32x2){vb.x, vb.y}; gb[m][1] = (u32x2){vb.z, vb.w};
        }
      }
      __builtin_amdgcn_sched_barrier(0);
#pragma unroll
      for (int m = 0; m < 4; ++m) {
        const int row = row0 + ai * 128 + m * 16;
        float rf = (p == 4) ? (1.f / 255.f) : 1.f;
        if (p >= 1 && p <= 3) { const int rl_ = row - u.pm * 256; const float r0 = rsl[2 * rl_], r1 = rsl[2 * rl_ + 1]; rf = (p == 1) ? __builtin_amdgcn_rcpf(r0) : (p == 2) ? r0 * __builtin_amdgcn_rcpf(r1) : r1; }
#pragma unroll
        for (int bj = 0; bj < 2; ++bj) {
          float f[8];
          if (p != 2) {
            const u32x2 a = ga[m][bj], b = gb[m][bj];
            const float d0 = (p == 4) ? 1.f : __builtin_amdgcn_rcpf(ub0(b.x)), d1 = (p == 4) ? 1.f : __builtin_amdgcn_rcpf(ub1(b.x)), d2 = (p == 4) ? 1.f : __builtin_amdgcn_rcpf(ub2(b.x)), d3 = (p == 4) ? 1.f : __builtin_amdgcn_rcpf(ub3(b.x));
            const float d4 = (p == 4) ? 1.f : __builtin_amdgcn_rcpf(ub0(b.y)), d5 = (p == 4) ? 1.f : __builtin_amdgcn_rcpf(ub1(b.y)), d6 = (p == 4) ? 1.f : __builtin_amdgcn_rcpf(ub2(b.y)), d7 = (p == 4) ? 1.f : __builtin_amdgcn_rcpf(ub3(b.y));
            f[0] = rf * ub0(a.x) * d0; f[1] = rf * ub1(a.x) * d1; f[2] = rf * ub2(a.x) * d2; f[3] = rf * ub3(a.x) * d3;
            f[4] = rf * ub0(a.y) * d4; f[5] = rf * ub1(a.y) * d5; f[6] = rf * ub2(a.y) * d6; f[7] = rf * ub3(a.y) * d7;
          } else {
#pragma unroll
            for (int j = 0; j < 8; ++j) f[j] = rf;
          }
          acc[ai][bj][m][0] = acc[ai][bj][m][0] * (f32x4){f[0], f[1], f[2], f[3]};
          acc[ai][bj][m][1] = acc[ai][bj][m][1] * (f32x4){f[4], f[5], f[6], f[7]};
          if (p == 4) {
            const f32x4 v0 = acc[ai][bj][m][0], v1 = acc[ai][bj][m][1];
            u32x4 w; w.x = pg8::cvt_pk_bf16(v0[0], v0[1]); w.y = pg8::cvt_pk_bf16(v0[2], v0[3]); w.z = pg8::cvt_pk_bf16(v1[0], v1[1]); w.w = pg8::cvt_pk_bf16(v1[2], v1[3]);
            *(u32x4*)(MERGED + (size_t)row * D + col0 + bj * 128) = w;
          }
        }
      }
      __builtin_amdgcn_sched_barrier(0);
    }
  }
};
struct SchedOut {
  const char* A; const char* B; int G, c;
  __device__ __forceinline__ bool next(int i, pg8::Unit& u) const {
    const int L = i * G + c; if (L >= 32 * 8) return false;
    pg8::tile_of(L, 32, 8, u.pm, u.pn); u.aux = 0; u.nt = D / 64;
    u.A = A + (size_t)u.pm * 256 * D * 2; u.B = B + (size_t)u.pn * 256 * D * 2; return true;
  }
};

struct EpiProj {
  static constexpr bool PERM = true, KEEP = false, I8 = false;
  bf16_t* P; unsigned char* G8;
  __device__ __forceinline__ void operator()(const f32x4 (&acc)[2][2][4][2], const pg8::Unit& u, int wr, int wc, int fr_, int fq_) const {
    const int fr = launder(fr_), fq = launder(fq_);
    const int row0 = u.pm * 256 + wr * 64 + fr;
    if (u.pn >= P_GLU / 256 && u.pn < P_GLU / 256 + 8) {
      const int colg = P_GLU + 128 * (u.pn - P_GLU / 256) + wc * 32 + 8 * fq;
#pragma unroll
      for (int ai = 0; ai < 2; ++ai)
#pragma unroll
        for (int m = 0; m < 4; ++m) {
          const f32x4 v0 = acc[ai][0][m][0], v1 = acc[ai][0][m][1], g0 = acc[ai][1][m][0], g1 = acc[ai][1][m][1];
          u32x4 w; w.x = pg8::cvt_pk_bf16(v0[0] * sigm_fast(g0[0]), v0[1] * sigm_fast(g0[1])); w.y = pg8::cvt_pk_bf16(v0[2] * sigm_fast(g0[2]), v0[3] * sigm_fast(g0[3]));
          w.z = pg8::cvt_pk_bf16(v1[0] * sigm_fast(g1[0]), v1[1] * sigm_fast(g1[1])); w.w = pg8::cvt_pk_bf16(v1[2] * sigm_fast(g1[2]), v1[3] * sigm_fast(g1[3]));
          *(u32x4*)(P + (size_t)(row0 + ai * 128 + m * 16) * LDP + colg) = w;
        }
      return;
    }
    if (u.pn >= P_MG / 256) {
      const int colg = (u.pn - P_MG / 256) * 256 + wc * 32 + 8 * fq;
#pragma unroll
      for (int ai = 0; ai < 2; ++ai)
#pragma unroll
        for (int m = 0; m < 4; ++m)
#pragma unroll
          for (int bj = 0; bj < 2; ++bj) {
            const f32x4 v0 = acc[ai][bj][m][0], v1 = acc[ai][bj][m][1];
            unsigned q[8];
#pragma unroll
            for (int j = 0; j < 4; ++j) { q[j] = (unsigned)fmaxf(__builtin_rintf(255.f * sigm_fast(v0[j])), 1.f); q[4 + j] = (unsigned)fmaxf(__builtin_rintf(255.f * sigm_fast(v1[j])), 1.f); }
            u32x2 w; w.x = q[0] | (q[1] << 8) | (q[2] << 16) | (q[3] << 24); w.y = q[4] | (q[5] << 8) | (q[6] << 16) | (q[7] << 24);
            *(u32x2*)(G8 + (size_t)(row0 + ai * 128 + m * 16) * 8192 + colg + bj * 128) = w;
          }
      return;
    }
    const int col0 = u.pn * 256 + wc * 32 + 8 * fq;
#pragma unroll
    for (int ai = 0; ai < 2; ++ai)
#pragma unroll
      for (int m = 0; m < 4; ++m) { bf16_t* rowp = P + (size_t)(row0 + ai * 128 + m * 16) * LDP + col0;
#pragma unroll
        for (int bj = 0; bj < 2; ++bj) { const f32x4 v0 = acc[ai][bj][m][0], v1 = acc[ai][bj][m][1];
          u32x4 w; w.x = pg8::cvt_pk_bf16(v0[0], v0[1]); w.y = pg8::cvt_pk_bf16(v0[2], v0[3]); w.z = pg8::cvt_pk_bf16(v1[0], v1[1]); w.w = pg8::cvt_pk_bf16(v1[2], v1[3]);
          *(u32x4*)(rowp + bj * 128) = w; } }
  }
};
struct EpiGate8 {
  static constexpr bool PERM = true, KEEP = false, I8 = true;
  unsigned char* G8; const float* SH; const float* SW; bf16_t* P;
  __device__ __forceinline__ void operator()(const f32x4 (&acc)[2][2][4][2], const pg8::Unit& u, int wr, int wc, int fr_, int fq_) const {
    const int fr = launder(fr_), fq = launder(fq_);
    const int row0 = u.pm * 256 + wr * 64 + fr, colg = u.pn * 256 + wc * 32 + 8 * fq;
    f32x4 sw[2][2];
#pragma unroll
    for (int bj = 0; bj < 2; ++bj) { sw[bj][0] = *(const f32x4*)(SW + colg + bj * 128); sw[bj][1] = *(const f32x4*)(SW + colg + bj * 128 + 4); }
    if (u.pn >= 32) {
      const int colp = np_of_t8(u.pn) + wc * 32 + 8 * fq;
#pragma unroll
      for (int ai = 0; ai < 2; ++ai)
#pragma unroll
        for (int m = 0; m < 4; ++m) {
          const int row = row0 + ai * 128 + m * 16;
          const float sh = SH[row];
#pragma unroll
          for (int bj = 0; bj < 2; ++bj) {
            const i32x4 a0 = __builtin_bit_cast(i32x4, acc[ai][bj][m][0]), a1 = __builtin_bit_cast(i32x4, acc[ai][bj][m][1]);
            u32x4 w; w.x = pg8::cvt_pk_bf16((float)a0[0] * sh * sw[bj][0][0], (float)a0[1] * sh * sw[bj][0][1]); w.y = pg8::cvt_pk_bf16((float)a0[2] * sh * sw[bj][0][2], (float)a0[3] * sh * sw[bj][0][3]);
            w.z = pg8::cvt_pk_bf16((float)a1[0] * sh * sw[bj][1][0], (float)a1[1] * sh * sw[bj][1][1]); w.w = pg8::cvt_pk_bf16((float)a1[2] * sh * sw[bj][1][2], (float)a1[3] * sh * sw[bj][1][3]);
            *(u32x4*)(P + (size_t)row * LDP + colp + bj * 128) = w;
          }
        }
      return;
    }
    unsigned char* gblk = G8 + ((size_t)(((u.pn >> 3) * 32 + u.pm) * 8 + (u.pn & 7)) << 16) + (size_t)(((wr * 4 + wc) * 64 + fr + 16 * fq) * 16);
#pragma unroll
    for (int ai = 0; ai < 2; ++ai)
#pragma unroll
      for (int m = 0; m < 4; ++m) {
        const int row = row0 + ai * 128 + m * 16;
        const float sh = SH[row];
        u32x4 w4;
#pragma unroll
        for (int bj = 0; bj < 2; ++bj) {
          const i32x4 a0 = __builtin_bit_cast(i32x4, acc[ai][bj][m][0]), a1 = __builtin_bit_cast(i32x4, acc[ai][bj][m][1]);
          unsigned q[8];
#pragma unroll
          for (int j = 0; j < 4; ++j) { q[j] = (unsigned)fmaxf(__builtin_rintf(255.f * sigm_fast((float)a0[j] * sh * sw[bj][0][j])), 1.f); q[4 + j] = (unsigned)fmaxf(__builtin_rintf(255.f * sigm_fast((float)a1[j] * sh * sw[bj][1][j])), 1.f); }
          const unsigned lo = q[0] | (q[1] << 8) | (q[2] << 16) | (q[3] << 24), hi_ = q[4] | (q[5] << 8) | (q[6] << 16) | (q[7] << 24);
          if (bj == 0) { w4.x = lo; w4.y = hi_; } else { w4.z = lo; w4.w = hi_; }
        }
        *(u32x4*)(gblk + (ai * 4 + m) * 8192) = w4;
      }
  }
};
struct EpiOut {
  static constexpr bool PERM = true, KEEP = false, I8 = false;
  const void* xin; void* xout; int mode;
  __device__ __forceinline__ void operator()(const f32x4 (&acc)[2][2][4][2], const pg8::Unit& u, int wr, int wc, int fr_, int fq_) const {
    const int fr = launder(fr_), fq = launder(fq_);
    const int row0 = u.pm * 256 + wr * 64 + fr, col0 = u.pn * 256 + wc * 32 + 8 * fq;
    if (mode == 0) {
      const float* xi = (const float*)xin; bf16_t* xo = (bf16_t*)xout;
#pragma unroll
      for (int ai = 0; ai < 2; ++ai) {
        f32x4 b[4][2][2];
#pragma unroll
        for (int m = 0; m < 4; ++m) { const size_t off = (size_t)(row0 + ai * 128 + m * 16) * D + col0;
#pragma unroll
          for (int bj = 0; bj < 2; ++bj)
#pragma unroll
            for (int n = 0; n < 2; ++n) b[m][bj][n] = *(const f32x4*)(xi + off + bj * 128 + n * 4); }
        __builtin_amdgcn_sched_barrier(0);
#pragma unroll
        for (int m = 0; m < 4; ++m) { const size_t off = (size_t)(row0 + ai * 128 + m * 16) * D + col0;
#pragma unroll
          for (int bj = 0; bj < 2; ++bj) { const f32x4 v0 = b[m][bj][0] + acc[ai][bj][m][0], v1 = b[m][bj][1] + acc[ai][bj][m][1];
            u32x4 w; w.x = pg8::cvt_pk_bf16(v0[0], v0[1]); w.y = pg8::cvt_pk_bf16(v0[2], v0[3]); w.z = pg8::cvt_pk_bf16(v1[0], v1[1]); w.w = pg8::cvt_pk_bf16(v1[2], v1[3]);
            *(u32x4*)(xo + off + bj * 128) = w; } }
        __builtin_amdgcn_sched_barrier(0);
      }
    } else {
      const bf16_t* xi = (const bf16_t*)xin; bf16_t* xo = (bf16_t*)xout;
#pragma unroll
      for (int ai = 0; ai < 2; ++ai) {
        u32x4 b[4][2];
#pragma unroll
        for (int m = 0; m < 4; ++m) { const size_t off = (size_t)(row0 + ai * 128 + m * 16) * D + col0;
#pragma unroll
          for (int bj = 0; bj < 2; ++bj) b[m][bj] = *(const u32x4*)(xi + off + bj * 128); }
        __builtin_amdgcn_sched_barrier(0);
#pragma unroll
        for (int m = 0; m < 4; ++m) { const size_t off = (size_t)(row0 + ai * 128 + m * 16) * D + col0;
#pragma unroll
          for (int bj = 0; bj < 2; ++bj) { const u32x4 r = b[m][bj];
            const f32x4 v0 = (f32x4){bflo(r.x), bfhi(r.x), bflo(r.y), bfhi(r.y)} + acc[ai][bj][m][0], v1 = (f32x4){bflo(r.z), bfhi(r.z), bflo(r.w), bfhi(r.w)} + acc[ai][bj][m][1];
            u32x4 w; w.x = pg8::cvt_pk_bf16(v0[0], v0[1]); w.y = pg8::cvt_pk_bf16(v0[2], v0[3]); w.z = pg8::cvt_pk_bf16(v1[0], v1[1]); w.w = pg8::cvt_pk_bf16(v1[2], v1[3]);
            *(u32x4*)(xo + off + bj * 128) = w; } }
        __builtin_amdgcn_sched_barrier(0);
      }
    }
  }
};

#define REP_CONVW 1
#define REP_INPROJ 1
#define REP_MIX 1
#define REP_MERGE 1
#define REP_OUT 1
#define REP_PREMIX 1
#ifndef FAST_A
#define FAST_A 1
#endif
#ifndef FAST_B
#define FAST_B 1
#endif
#ifndef FAST_D
#define FAST_D 1
#endif
#ifndef FAST_C
#define FAST_C 1
#endif
typedef float f32x16 __attribute__((ext_vector_type(16)));
constexpr float LOG2E = 1.4426950408889634f;
__device__ __forceinline__ int t5_bucket_fast(int n) {
  if (n < 16) return n;
  const float v = __builtin_amdgcn_logf((float)n * 0.0625f) * (16.f / 3.f);
  const int l = 16 + (int)v;
  return l < 31 ? l : 31;
}
constexpr float QSCALE = 0.125f * LOG2E;
__device__ __forceinline__ int crow(int r, int hi) { return (r & 3) + 8 * (r >> 2) + 4 * hi; }
__device__ __forceinline__ float ex2(float x) { return __builtin_amdgcn_exp2f(x); }
__device__ __forceinline__ float silu_fast(float x) { return x * __builtin_amdgcn_rcpf(1.f + ex2(-LOG2E * x)); }
__device__ __forceinline__ unsigned cvtpk(float lo, float hi) { unsigned r; asm("v_cvt_pk_bf16_f32 %0, %1, %2" : "=v"(r) : "v"(lo), "v"(hi)); return r; }

__device__ __forceinline__ void load_qf(bf16x8 (&qf)[4], const bf16_t* qrow  ) {
#pragma unroll
  for (int d0 = 0; d0 < 4; ++d0) {
    const u32x4 w = *(const u32x4*)(qrow + 16 * d0);
    u32x4 o;
    o.x = cvtpk(bflo(w.x) * QSCALE, bfhi(w.x) * QSCALE); o.y = cvtpk(bflo(w.y) * QSCALE, bfhi(w.y) * QSCALE);
    o.z = cvtpk(bflo(w.z) * QSCALE, bfhi(w.z) * QSCALE); o.w = cvtpk(bflo(w.w) * QSCALE, bfhi(w.w) * QSCALE);
    qf[d0] = __builtin_bit_cast(bf16x8, o);
  }
}
__device__ __forceinline__ void st_tile(f32x16& p0, f32x16& p1, const LAS unsigned char* kb, const int kstride, const bf16x8 (&qf)[4], const float cinit) {
#pragma unroll
  for (int r = 0; r < 16; ++r) { p0[r] = cinit; p1[r] = cinit; }
#pragma unroll
  for (int d0 = 0; d0 < 4; ++d0) {
    const bf16x8 a0 = *(const LAS bf16x8*)(kb + d0 * 32);
    const bf16x8 a1 = *(const LAS bf16x8*)(kb + 32 * kstride + d0 * 32);
    p0 = __builtin_amdgcn_mfma_f32_32x32x16_bf16(a0, qf[d0], p0, 0, 0, 0);
    p1 = __builtin_amdgcn_mfma_f32_32x32x16_bf16(a1, qf[d0], p1, 0, 0, 0);
  }
}
template <int SS_>
__device__ __forceinline__ bf16x8 pack8(const f32x16& p) {
  u32x4 w; w.x = cvtpk(p[8 * SS_ + 0], p[8 * SS_ + 1]); w.y = cvtpk(p[8 * SS_ + 2], p[8 * SS_ + 3]); w.z = cvtpk(p[8 * SS_ + 4], p[8 * SS_ + 5]); w.w = cvtpk(p[8 * SS_ + 6], p[8 * SS_ + 7]);
  return __builtin_bit_cast(bf16x8, w);
}
template <int NE>
__device__ __forceinline__ void pv_step(f32x16 (&o)[NE], const bf16x8 pk, const LAS unsigned char* vt, const int vstride) {
#pragma unroll
  for (int je = 0; je < NE; ++je) {
    const u32x2 lo = *(const LAS u32x2*)(vt + je * 32 * vstride);
    const u32x2 hi2 = *(const LAS u32x2*)(vt + je * 32 * vstride + 16);
    const u32x4 a = (u32x4){lo.x, lo.y, hi2.x, hi2.y};
    o[je] = __builtin_amdgcn_mfma_f32_32x32x16_bf16(__builtin_bit_cast(bf16x8, a), pk, o[je], 0, 0, 0);
  }
}
template <int NE>
__device__ __forceinline__ void softmax_pv(f32x16& p0, f32x16& p1, float& m, float& l, f32x16 (&o)[NE], const LAS unsigned char* vt, const int vstride) {
  float mx = fmaxf(p0[0], p1[0]);
#pragma unroll
  for (int r = 1; r < 16; ++r) mx = fmaxf(mx, fmaxf(p0[r], p1[r]));
  mx = fmaxf(mx, __shfl_xor(mx, 32));
  const float mn = fmaxf(m, mx);
  const float alpha = ex2(m - mn);
  m = mn;
  float sum = 0.f;
#pragma unroll
  for (int r = 0; r < 16; ++r) { p0[r] = ex2(p0[r] - mn); p1[r] = ex2(p1[r] - mn); sum += p0[r] + p1[r]; }
  l = l * alpha + sum;
#pragma unroll
  for (int je = 0; je < NE; ++je) o[je] = o[je] * alpha;
  pv_step<NE>(o, pack8<0>(p0), vt, vstride);
  pv_step<NE>(o, pack8<1>(p0), vt + 32, vstride);
  pv_step<NE>(o, pack8<0>(p1), vt + 64, vstride);
  pv_step<NE>(o, pack8<1>(p1), vt + 96, vstride);
}

__device__ __forceinline__ unsigned off_b(unsigned row, unsigned ch) { return 256u * row + 16u * (ch ^ (((row & 3u) << 2) | ((row >> 2) & 3u))); }
struct LaneB { unsigned xr, q, T0, T1, N0, N1; };
__device__ __forceinline__ LaneB lane_b(int lane) {
  const unsigned h = lane >> 5, blk = (lane >> 4) & 1, q = (lane & 15) >> 2, p = lane & 3, ch0 = 2 * blk + (p >> 1), r32 = lane & 31;
  LaneB L; L.q = q; L.xr = ((r32 & 3) << 2) | ((r32 >> 2) & 3);
  L.T0 = 256 * (4 * h + q) + 16 * (ch0 ^ h) + 8 * (p & 1);
  L.T1 = 256 * (8 + 4 * h + q) + 16 * (ch0 ^ (2 + h)) + 8 * (p & 1);
  L.N0 = 256 * (8 * h + q) + 16 * (ch0 ^ ((2 * h) & 3)) + 8 * (p & 1);
  L.N1 = 256 * (8 * h + 4 + q) + 16 * (ch0 ^ ((2 * h + 1) & 3)) + 8 * (p & 1);
  return L;
}
typedef short v4i16_t __attribute__((ext_vector_type(4)));
__device__ __forceinline__ u32x2 tr_rd(const LAS unsigned char* p) { return __builtin_bit_cast(u32x2, __builtin_amdgcn_ds_read_tr16_b64_v4i16((LAS v4i16_t*)p)); }
__device__ __forceinline__ void st_tile_b(f32x16& p0, f32x16& p1, const LAS unsigned char* kt, const unsigned (&ko)[4], const bf16x8 (&qf)[4], const float cinit) {
  bf16x8 a[8];
#pragma unroll
  for (int d0 = 0; d0 < 4; ++d0) { a[2 * d0] = *(const LAS bf16x8*)(kt + ko[d0]); a[2 * d0 + 1] = *(const LAS bf16x8*)(kt + 8192 + ko[d0]); }
#pragma unroll
  for (int r = 0; r < 16; ++r) { p0[r] = cinit; p1[r] = cinit; }
  __builtin_amdgcn_sched_barrier(0);
#pragma unroll
  for (int d0 = 0; d0 < 4; ++d0) {
    p0 = __builtin_amdgcn_mfma_f32_32x32x16_bf16(a[2 * d0], qf[d0], p0, 0, 0, 0);
    p1 = __builtin_amdgcn_mfma_f32_32x32x16_bf16(a[2 * d0 + 1], qf[d0], p1, 0, 0, 0);
  }
}
template <int NE>
__device__ __forceinline__ void pv_tr4(f32x16 (&o)[NE], const bf16x8 (&pk)[4], const LAS unsigned char* vb, const unsigned (&a0)[NE], const unsigned (&a1)[NE]) {
  u32x2 f[2][NE][2];
#pragma unroll
  for (int je = 0; je < NE; ++je) { f[0][je][0] = tr_rd(vb + a0[je]); f[0][je][1] = tr_rd(vb + a1[je]); }
#pragma unroll
  for (int s = 0; s < 4; ++s) {
    if (s < 3) {
#pragma unroll
      for (int je = 0; je < NE; ++je) { f[(s + 1) & 1][je][0] = tr_rd(vb + 4096 * (s + 1) + a0[je]); f[(s + 1) & 1][je][1] = tr_rd(vb + 4096 * (s + 1) + a1[je]); }
    }
    __builtin_amdgcn_sched_barrier(0);
#pragma unroll
    for (int je = 0; je < NE; ++je) {
      const u32x4 a = (u32x4){f[s & 1][je][0].x, f[s & 1][je][0].y, f[s & 1][je][1].x, f[s & 1][je][1].y};
      o[je] = __builtin_amdgcn_mfma_f32_32x32x16_bf16(__builtin_bit_cast(bf16x8, a), pk[s], o[je], 0, 0, 0);
    }
    __builtin_amdgcn_sched_barrier(0);
  }
}
template <int NE>
__device__ __forceinline__ void softmax_pv_tr(f32x16& p0, f32x16& p1, float& m, float& l, f32x16 (&o)[NE], const LAS unsigned char* vb, const unsigned (&a0)[NE], const unsigned (&a1)[NE]) {
  float mxa = fmaxf(fmaxf(p0[0], p1[0]), fmaxf(p0[1], p1[1])), mxb = fmaxf(fmaxf(p0[2], p1[2]), fmaxf(p0[3], p1[3]));
#pragma unroll
  for (int r = 4; r < 16; r += 2) { mxa = fmaxf(fmaxf(mxa, p0[r]), p1[r]); mxb = fmaxf(fmaxf(mxb, p0[r + 1]), p1[r + 1]); }
  float mx = fmaxf(mxa, mxb);
  mx = fmaxf(mx, __shfl_xor(mx, 32));
  if (!__all(mx <= m + 8.f)) {
    const float mn = fmaxf(m, mx);
    const float alpha = ex2(m - mn);
    m = mn; l = l * alpha;
#pragma unroll
    for (int je = 0; je < NE; ++je) o[je] = o[je] * alpha;
  }
  float s0 = 0.f, s1 = 0.f;
#pragma unroll
  for (int r = 0; r < 16; ++r) { p0[r] = ex2(p0[r] - m); p1[r] = ex2(p1[r] - m); s0 += p0[r]; s1 += p1[r]; }
  l += s0 + s1;
  const bf16x8 pk[4] = {pack8<0>(p0), pack8<1>(p0), pack8<0>(p1), pack8<1>(p1)};
  pv_tr4<NE>(o, pk, vb, a0, a1);
}

constexpr int A_SLOT = 32768, A_SUP = 2 * A_SLOT, A_TAB = 2 * A_SUP;
__device__ __forceinline__ void glds16(const void* g, LAS unsigned char* l) { __builtin_amdgcn_global_load_lds((const unsigned*)g, (LAS unsigned*)l, 16, 0, 0); }
__device__ __forceinline__ void unit_A(LAS unsigned char* lds, const bf16_t* __restrict__ P, const float* __restrict__ rel_bias, const float* __restrict__ subln_w,
                                       const float lam, const int layer, bf16_t* __restrict__ BR, const int unit) {
  const int tid = launder((int)threadIdx.x), lane = tid & 63, wave = __builtin_amdgcn_readfirstlane(tid >> 6), r32 = lane & 31, hi = lane >> 5;
  const int qb = 15 - unit / 32, bh = unit % 32, b = bh >> 3, h = bh & 7;
  const int rg = wave >> 1, m = wave & 1;
  if (wave >= 4) __builtin_amdgcn_s_setprio(1);
  const size_t rowbase = (size_t)b * S;
  const int ntiles = 2 * qb + 2;
  const bf16_t* ksrc[2]; const bf16_t* vsrc[2];
#pragma unroll
  for (int i = 0; i < 2; ++i) {
    const int row = 4 * (2 * wave + i) + (lane >> 4), pos = lane & 15, ch = pos ^ (((row & 3) << 2) | ((row >> 2) & 3));
    ksrc[i] = P + (rowbase + row) * LDP + PA_K + h * 128 + ch * 8;
    vsrc[i] = P + (rowbase + row) * LDP + PA_V + h * 128 + ch * 8;
  }
#define A_DMA(j, base) do { const size_t o_ = (size_t)(j) * 64 * LDP; LAS unsigned char* d_ = (base) + (2 * wave) * 1024; \
    glds16(ksrc[0] + o_, d_); glds16(ksrc[1] + o_, d_ + 1024); glds16(vsrc[0] + o_, d_ + 16384); glds16(vsrc[1] + o_, d_ + 16384 + 1024); } while (0)
  A_DMA(0, lds); A_DMA(1, lds + A_SLOT);
  LAS float* tab = (LAS float*)(lds + A_TAB);
  if (tid < 320) { const int d = tid - 96; tab[tid] = d < 0 ? -INFINITY : (rel_bias[t5_bucket_fast(d < 128 ? d : 128) * 24 + h] - rel_bias[31 * 24 + h]) * LOG2E; }
  const int qrow = 128 * qb + 32 * rg + r32;
  bf16x8 qf[4];
  load_qf(qf, P + (rowbase + qrow) * LDP + PA_Q + h * 128 + m * 64 + 8 * hi);
  const LaneB LB = lane_b(lane);
  unsigned ko[4], va0[4], va1[4];
#pragma unroll
  for (int d0 = 0; d0 < 4; ++d0) ko[d0] = 256u * r32 + 16u * ((unsigned)(8 * m + 2 * d0 + hi) ^ LB.xr);
#pragma unroll
  for (int je = 0; je < 4; ++je) { va0[je] = LB.T0 + 64u * ((unsigned)je ^ LB.q); va1[je] = LB.T1 + 64u * ((unsigned)je ^ LB.q); }
  float mst = -INFINITY, lst = 0.f;
  f32x16 o[4];
#pragma unroll
  for (int je = 0; je < 4; ++je)
#pragma unroll
    for (int r = 0; r < 16; ++r) o[je][r] = 0.f;
  const int qmin = 128 * qb + 32 * rg;
  const int nst = qb + 1;
  for (int J = 0; J < nst; ++J) {
    asm volatile("s_waitcnt vmcnt(0) lgkmcnt(0)" ::: "memory");
    __builtin_amdgcn_s_barrier();
    asm volatile("" ::: "memory");
    if (J + 1 < nst) { LAS unsigned char* nb_ = lds + ((J + 1) & 1) * A_SUP; A_DMA(2 * J + 2, nb_); A_DMA(2 * J + 3, nb_ + A_SLOT); }
#pragma unroll
    for (int t = 0; t < 2; ++t) {
      const int j = 2 * J + t;
      if (64 * j <= qmin + 31) {
        const LAS unsigned char* kt = lds + (J & 1) * A_SUP + t * A_SLOT;
        const bool far = (qmin - (64 * j + 63)) >= 128;
        f32x16 p0, p1;
        st_tile_b(p0, p1, kt, ko, qf, 0.f);
        if (!far) {
          const LAS float* tb = tab + (qrow - 64 * j - 4 * hi + 96 - 59);
          float tv0[16], tv1[16];
#pragma unroll
          for (int r = 0; r < 16; ++r) { const int cr = (r & 3) + 8 * (r >> 2); tv0[r] = tb[59 - cr]; tv1[r] = tb[27 - cr]; }
          __builtin_amdgcn_sched_barrier(0);
#pragma unroll
          for (int r = 0; r < 16; ++r) { p0[r] += tv0[r]; p1[r] += tv1[r]; }
        }
        softmax_pv_tr<4>(p0, p1, mst, lst, o, kt + 16384, va0, va1);
      }
    }
  }
#undef A_DMA
  const float ltot = lst + __shfl_xor(lst, 32);
  const float inv = 1.f / ltot;
  u32x4 gpre[4][2];
  if (m == 0) {
#pragma unroll
    for (int je = 0; je < 4; ++je)
#pragma unroll
      for (int gp = 0; gp < 2; ++gp) gpre[je][gp] = *(const u32x4*)(P + (rowbase + qrow) * LDP + PA_G + h * 128 + 32 * je + 8 * (2 * gp + hi));
  }
  __syncthreads();
  LAS float* ex = (LAS float*)lds + rg * 4096;
  if (m == 1) {
#pragma unroll
    for (int je = 0; je < 4; ++je)
#pragma unroll
      for (int r = 0; r < 16; ++r) ex[(je * 16 + r) * 64 + lane] = o[je][r] * inv;
  }
  __syncthreads();
  if (m == 0) {
    float ssq = 0.f;
#pragma unroll
    for (int je = 0; je < 4; ++je)
#pragma unroll
      for (int r = 0; r < 16; ++r) { const float a = o[je][r] * inv - lam * ex[(je * 16 + r) * 64 + lane]; o[je][r] = a; ssq += a * a; }
    ssq += __shfl_xor(ssq, 32);
    const float rn = rsqrtf(ssq * (1.f / 128.f) + EPS) * ((launder(layer) == 0) ? 0.8f : (float)(1.0 - (0.8 - 0.6 * 0.7408182206817179)));
    const size_t row = rowbase + qrow;
#pragma unroll
    for (int je = 0; je < 4; ++je)
#pragma unroll
      for (int gp = 0; gp < 2; ++gp) {
        const u32x2 s1 = __builtin_amdgcn_permlane32_swap(gpre[je][gp].x, gpre[je][gp].z, false, false), s2 = __builtin_amdgcn_permlane32_swap(gpre[je][gp].y, gpre[je][gp].w, false, false);
        u32x2 ovv[2];
#pragma unroll
        for (int q = 0; q < 2; ++q) {
          const int g4 = 2 * gp + q, e0 = 32 * je + 8 * g4 + 4 * hi;
          const f32x4 w4 = *(const f32x4*)(subln_w + e0);
          const u32x2 gw = q == 0 ? (u32x2){s1.x, s2.x} : (u32x2){s1.y, s2.y};
          const float v0 = o[je][4 * g4 + 0] * rn * w4[0] * silu_fast(bflo(gw.x)), v1 = o[je][4 * g4 + 1] * rn * w4[1] * silu_fast(bfhi(gw.x));
          const float v2 = o[je][4 * g4 + 2] * rn * w4[2] * silu_fast(bflo(gw.y)), v3 = o[je][4 * g4 + 3] * rn * w4[3] * silu_fast(bfhi(gw.y));
          ovv[q].x = cvtpk(v0, v1); ovv[q].y = cvtpk(v2, v3);
        }
        const u32x2 t1 = __builtin_amdgcn_permlane32_swap(ovv[0].x, ovv[1].x, false, false), t2 = __builtin_amdgcn_permlane32_swap(ovv[0].y, ovv[1].y, false, false);
        *(u32x4*)(BR + row * LDBR + h * 128 + 32 * je + 8 * (2 * gp + hi)) = (u32x4){t1.x, t2.x, t1.y, t2.y};
      }
  }
  __builtin_amdgcn_s_setprio(0);
}

constexpr int B_IMG = 256 * 256, B_BTAB = B_IMG;
__device__ __forceinline__ void unit_B(LAS unsigned char* lds, const bf16_t* __restrict__ P, const float* __restrict__ rel_bias, const float* __restrict__ sinks,
                                       bf16_t* __restrict__ BR, const int unit) {
  const int tid = launder((int)threadIdx.x), lane = tid & 63, wave = __builtin_amdgcn_readfirstlane(tid >> 6), r32 = lane & 31, hi = lane >> 5;
  const int b = unit >> 6, kv = (unit >> 4) & 3, qb = unit & 15;
  const size_t rowbase = (size_t)b * S;
  LAS float* btab = (LAS float*)(lds + B_BTAB);
#pragma unroll
  for (int i3 = 0; i3 < 3; ++i3) { const int i = tid + 512 * i3, gg = i / 384, dd = i % 384 - 127;
    btab[i] = (dd >= 0 && dd < 128) ? rel_bias[t5_bucket_fast(dd) * 24 + 8 + kv * 4 + gg] * LOG2E : -INFINITY; }
  {
    const int kk = tid >> 1, half = tid & 1, pos = 128 * (qb - 1) + kk;
    if (pos >= 0) {
      const bf16_t* kg = P + (rowbase + pos) * LDP + PB_K + kv * 64 + half * 32;
      const bf16_t* vg = P + (rowbase + pos) * LDP + PB_V + kv * 64 + half * 32;
      u32x4 kr[4], vr[4];
#pragma unroll
      for (int i = 0; i < 4; ++i) { kr[i] = *(const u32x4*)(kg + 8 * i); vr[i] = *(const u32x4*)(vg + 8 * i); }
#pragma unroll
      for (int i = 0; i < 4; ++i) { *(LAS u32x4*)(lds + off_b(kk, 4 * half + i)) = kr[i]; *(LAS u32x4*)(lds + off_b(kk, 8 + 4 * half + i)) = vr[i]; }
    }
  }
  __syncthreads();
  const int g = wave >> 1, hb = kv * 4 + g;
  const float sink2 = sinks[hb] * LOG2E;
  const LaneB LB = lane_b(lane);
  unsigned ko[4], va0[2], va1[2];
#pragma unroll
  for (int d0 = 0; d0 < 4; ++d0) ko[d0] = 256u * r32 + 16u * ((unsigned)(2 * d0 + hi) ^ LB.xr);
#pragma unroll
  for (int je = 0; je < 2; ++je) { va0[je] = LB.T0 + 64u * ((unsigned)(2 + je) ^ LB.q); va1[je] = LB.T1 + 64u * ((unsigned)(2 + je) ^ LB.q); }
#pragma unroll 1
  for (int rgi = 0; rgi < 2; ++rgi) {
    const int rr = 32 * (2 * (wave & 1) + rgi);
    const int qrow = 128 * qb + rr + r32;
    bf16x8 qf[4];
    load_qf(qf, P + (rowbase + qrow) * LDP + PB_Q + hb * 64 + 8 * hi);
    float mst = sink2, lst = (hi == 0) ? 1.f : 0.f;
    f32x16 o[2];
#pragma unroll
    for (int je = 0; je < 2; ++je)
#pragma unroll
      for (int r = 0; r < 16; ++r) o[je][r] = 0.f;
    const int jlo = (rr + 1) >> 6, jhi = (rr + 159) >> 6;
    for (int j = jlo; j <= jhi; ++j) {
      if (qb == 0 && j < 2) continue;
      f32x16 p0, p1;
      st_tile_b(p0, p1, lds + 256 * 64 * j, ko, qf, 0.f);
      { const LAS float* tb = btab + g * 384 + (255 + rr + r32 - 64 * j - 4 * hi - 59);
        float tv0[16], tv1[16];
#pragma unroll
        for (int r = 0; r < 16; ++r) { const int cr = (r & 3) + 8 * (r >> 2); tv0[r] = tb[59 - cr]; tv1[r] = tb[27 - cr]; }
        __builtin_amdgcn_sched_barrier(0);
#pragma unroll
        for (int r = 0; r < 16; ++r) { p0[r] += tv0[r]; p1[r] += tv1[r]; } }
      softmax_pv_tr<2>(p0, p1, mst, lst, o, lds + 256 * 64 * j, va0, va1);
    }
    const float ltot = lst + __shfl_xor(lst, 32);
    const float inv = 1.f / ltot;
    const size_t row = rowbase + qrow;
    u32x4 g16[2][2];
#pragma unroll
    for (int je = 0; je < 2; ++je)
#pragma unroll
      for (int gp = 0; gp < 2; ++gp) g16[je][gp] = *(const u32x4*)(P + row * LDP + PB_G + hb * 64 + 32 * je + 8 * (2 * gp + hi));
#pragma unroll
    for (int je = 0; je < 2; ++je)
#pragma unroll
      for (int gp = 0; gp < 2; ++gp) {
        const u32x2 s1 = __builtin_amdgcn_permlane32_swap(g16[je][gp].x, g16[je][gp].z, false, false), s2 = __builtin_amdgcn_permlane32_swap(g16[je][gp].y, g16[je][gp].w, false, false);
        u32x2 ovv[2];
#pragma unroll
        for (int q = 0; q < 2; ++q) {
          const int g4 = 2 * gp + q;
          const u32x2 gw = q == 0 ? (u32x2){s1.x, s2.x} : (u32x2){s1.y, s2.y};
          const float v0 = o[je][4 * g4 + 0] * inv * silu_fast(bflo(gw.x)), v1 = o[je][4 * g4 + 1] * inv * silu_fast(bfhi(gw.x));
          const float v2 = o[je][4 * g4 + 2] * inv * silu_fast(bflo(gw.y)), v3 = o[je][4 * g4 + 3] * inv * silu_fast(bfhi(gw.y));
          ovv[q].x = cvtpk(v0, v1); ovv[q].y = cvtpk(v2, v3);
        }
        const u32x2 t1 = __builtin_amdgcn_permlane32_swap(ovv[0].x, ovv[1].x, false, false), t2 = __builtin_amdgcn_permlane32_swap(ovv[0].y, ovv[1].y, false, false);
        *(u32x4*)(BR + row * LDBR + 1024 + hb * 64 + 32 * je + 8 * (2 * gp + hi)) = (u32x4){t1.x, t2.x, t1.y, t2.y};
      }
  }
}

__device__ __forceinline__ float silu2_fast(float y, float g) { return (y * g) * __builtin_amdgcn_rcpf((1.f + ex2(-LOG2E * y)) * (1.f + ex2(-LOG2E * g))); }
__device__ __forceinline__ void unit_D(LAS unsigned char* lds, const bf16_t* __restrict__ P, const float* __restrict__ cw, const float* __restrict__ cb,
                                       const float* __restrict__ lnw, const float* __restrict__ lnb, bf16_t* __restrict__ BR, const int unit) {
  const int tid = launder((int)threadIdx.x), lane = tid & 63, wave = __builtin_amdgcn_readfirstlane(tid >> 6);
  const int t0 = unit * 32, tl0 = t0 & (S - 1), c = 2 * tid;
  typedef float f32x2 __attribute__((ext_vector_type(2)));
#pragma unroll
  for (int r = 0; r < 8; ++r) {
    const int i = wave + 8 * r;
    if (i < 62) {
      LAS unsigned char* d = lds + i * 2048;
      if (tl0 - 30 + i >= 0) { const bf16_t* gp = P + (size_t)(t0 - 30 + i) * LDP + P_GLU + 8 * lane; glds16(gp, d); glds16(gp + 512, d + 1024); }
      else { *(LAS u32x4*)(d + 16 * lane) = (u32x4){0u, 0u, 0u, 0u}; *(LAS u32x4*)(d + 1024 + 16 * lane) = (u32x4){0u, 0u, 0u, 0u}; }
    }
  }
  f32x2 w[31];
#pragma unroll
  for (int k = 0; k < 31; ++k) w[k] = *(const f32x2*)(cw + k * 1024 + c);
  const f32x2 bias = *(const f32x2*)(cb + c);
  u32x2 gw[4][4];
#pragma unroll
  for (int jj = 0; jj < 4; ++jj)
#pragma unroll
    for (int i = 0; i < 4; ++i) gw[jj][i] = *(const u32x2*)(P + (size_t)(t0 + 4 * wave + jj) * LDP + P_DG + 4 * lane + 256 * i);
  __builtin_amdgcn_sched_barrier(0);
  asm volatile("s_waitcnt vmcnt(0) lgkmcnt(0)" ::: "memory");
  __syncthreads();
  f32x2 acc[32];
#pragma unroll
  for (int j = 0; j < 32; ++j) acc[j] = bias;
  const LAS unsigned char* up = lds + 4 * tid;
#pragma unroll
  for (int ib = 0; ib < 8; ++ib) {
    unsigned vv[8];
#pragma unroll
    for (int ii = 0; ii < 8; ++ii) { const int i = 8 * ib + ii; if (i < 62) vv[ii] = *(const LAS unsigned*)(up + i * 2048); }
#pragma unroll
    for (int ii = 0; ii < 8; ++ii) { const int i = 8 * ib + ii; if (i < 62) {
      f32x2 u; u.x = bflo(vv[ii]); u.y = bfhi(vv[ii]);
#pragma unroll
      for (int j = 0; j < 32; ++j) { const int k = i - j; if (k >= 0 && k <= 30) acc[j] = acc[j] + w[k] * u; } } }
  }
  __syncthreads();
  LAS float* cs = (LAS float*)lds;
#pragma unroll
  for (int j = 0; j < 32; ++j) *(LAS f32x2*)(cs + j * 1024 + c) = acc[j];
  f32x4 lw[4], lb[4];
#pragma unroll
  for (int i = 0; i < 4; ++i) { lw[i] = *(const f32x4*)(lnw + 4 * lane + 256 * i); lb[i] = *(const f32x4*)(lnb + 4 * lane + 256 * i); }
  __syncthreads();
#pragma unroll
  for (int jj = 0; jj < 4; ++jj) {
    const int j = 4 * wave + jj; const size_t row = (size_t)t0 + j;
    f32x4 v[4]; float s = 0.f;
#pragma unroll
    for (int i = 0; i < 4; ++i) { v[i] = *(const LAS f32x4*)(cs + j * 1024 + 4 * lane + 256 * i); s += (v[i][0] + v[i][1]) + (v[i][2] + v[i][3]); }
    const float mean = wave_sum(s) * (1.f / 1024.f);
    float q = 0.f;
#pragma unroll
    for (int i = 0; i < 4; ++i) { v[i] = v[i] - mean; q += (v[i][0] * v[i][0] + v[i][1] * v[i][1]) + (v[i][2] * v[i][2] + v[i][3] * v[i][3]); }
    const float rstd = rsqrtf(wave_sum(q) * (1.f / 1024.f) + EPS);
#pragma unroll
    for (int i = 0; i < 4; ++i) {
      const int cc = 4 * lane + 256 * i;
      const u32x2 g2 = gw[jj][i];
      const f32x4 y = v[i] * rstd * lw[i] + lb[i];
      u32x2 ov; ov.x = cvtpk(silu2_fast(y[0], bflo(g2.x)), silu2_fast(y[1], bfhi(g2.x)));
      ov.y = cvtpk(silu2_fast(y[2], bflo(g2.y)), silu2_fast(y[3], bfhi(g2.y)));
      *(u32x2*)(BR + row * LDBR + 3072 + cc) = ov;
    }
  }
}

template <int NU>
__device__ __forceinline__ void unit_conv(const bf16_t* __restrict__ P, const float* __restrict__ cw, const float* __restrict__ cb, bf16_t* __restrict__ CONV, const int unit) {
  const int tid = launder((int)threadIdx.x);
  if (tid < 384) {
    const int c4 = tid * 4;
    u32x2 raw[NU][19];
#pragma unroll
    for (int q = 0; q < NU; ++q) {
      const int t0 = (unit + q) * 16, tl0 = t0 & (S - 1);
#pragma unroll
      for (int i = 0; i < 19; ++i) {
        if (tl0 - 3 + i >= 0) raw[q][i] = *(const u32x2*)(P + (size_t)(t0 - 3 + i) * LDP + P_XBC + c4);
        else raw[q][i] = (u32x2){0u, 0u};
      }
    }
    f32x4 w[4];
#pragma unroll
    for (int k = 0; k < 4; ++k) w[k] = *(const f32x4*)(cw + k * 1536 + c4);
    const f32x4 bias = *(const f32x4*)(cb + c4);
#pragma unroll
    for (int q = 0; q < NU; ++q) {
      const int t0 = (unit + q) * 16;
      f32x4 r0 = (f32x4){bflo(raw[q][0].x), bfhi(raw[q][0].x), bflo(raw[q][0].y), bfhi(raw[q][0].y)};
      f32x4 r1 = (f32x4){bflo(raw[q][1].x), bfhi(raw[q][1].x), bflo(raw[q][1].y), bfhi(raw[q][1].y)};
      f32x4 r2 = (f32x4){bflo(raw[q][2].x), bfhi(raw[q][2].x), bflo(raw[q][2].y), bfhi(raw[q][2].y)};
#pragma unroll
      for (int j = 0; j < 16; ++j) {
        const f32x4 r3 = (f32x4){bflo(raw[q][j + 3].x), bfhi(raw[q][j + 3].x), bflo(raw[q][j + 3].y), bfhi(raw[q][j + 3].y)};
        const f32x4 v = bias + w[0] * r0 + w[1] * r1 + w[2] * r2 + w[3] * r3;
        u32x2 o; o.x = cvtpk(silu_fast(v[0]), silu_fast(v[1])); o.y = cvtpk(silu_fast(v[2]), silu_fast(v[3]));
        *(u32x2*)(CONV + (size_t)(t0 + j) * 1536 + c4) = o;
        r0 = r1; r1 = r2; r2 = r3;
      }
    }
  }
}
__device__ __forceinline__ void unit_dt(LAS unsigned char* lds, const bf16_t* __restrict__ Hb, const bf16_t* __restrict__ WdtT, const float* __restrict__ dt_bias, const float* __restrict__ a_log,
                                        float* __restrict__ DTA, const int unit) {
  const int tid = launder((int)threadIdx.x), lane = tid & 63, wave = __builtin_amdgcn_readfirstlane(tid >> 6);
  const size_t t0 = (size_t)unit * 128;
  typedef float f32x2 __attribute__((ext_vector_type(2)));
  f32x4 acc[8];
#pragma unroll
  for (int rt = 0; rt < 8; ++rt) acc[rt] = (f32x4){0.f, 0.f, 0.f, 0.f};
  const bf16_t* ap = Hb + (t0 + (lane & 15)) * D + 256 * wave + 8 * (lane >> 4);
  const bf16_t* bp = WdtT + (size_t)(lane & 15) * D + 256 * wave + 8 * (lane >> 4);
#pragma unroll
  for (int kh = 0; kh < 2; ++kh) {
    bf16x8 bfr[4], afr[8][4];
#pragma unroll
    for (int ks = 0; ks < 4; ++ks) bfr[ks] = *(const bf16x8*)(bp + 32 * (4 * kh + ks));
#pragma unroll
    for (int rt = 0; rt < 8; ++rt)
#pragma unroll
      for (int ks = 0; ks < 4; ++ks) afr[rt][ks] = *(const bf16x8*)(ap + (size_t)rt * 16 * D + 32 * (4 * kh + ks));
#pragma unroll
    for (int rt = 0; rt < 8; ++rt)
#pragma unroll
      for (int ks = 0; ks < 4; ++ks) acc[rt] = __builtin_amdgcn_mfma_f32_16x16x32_bf16(afr[rt][ks], bfr[ks], acc[rt], 0, 0, 0);
  }
  LAS float* part = (LAS float*)lds;
  LAS float* dtl = (LAS float*)(lds + 65536);
  __syncthreads();
#pragma unroll
  for (int rt = 0; rt < 8; ++rt)
#pragma unroll
    for (int r = 0; r < 4; ++r) part[(wave * 128 + 16 * rt + 4 * (lane >> 4) + r) * 16 + (lane & 15)] = acc[rt][r];
  __syncthreads();
  { const int row = tid >> 2, c4 = 4 * (tid & 3);
    f32x4 sum = (f32x4){0.f, 0.f, 0.f, 0.f};
#pragma unroll
    for (int w = 0; w < 8; ++w) sum += *(const LAS f32x4*)(part + (w * 128 + row) * 16 + c4);
    dtl[row * 17 + c4 + 0] = sum[0]; dtl[row * 17 + c4 + 1] = sum[1]; dtl[row * 17 + c4 + 2] = sum[2]; dtl[row * 17 + c4 + 3] = sum[3]; }
  __syncthreads();
#pragma unroll 1
  for (int hh = 0; hh < 2; ++hh) {
    const int h = 2 * wave + hh;
    const float a = -ex2(a_log[h] * LOG2E), dtb = dt_bias[h];
    const float v0 = dtl[(2 * lane) * 17 + h] + dtb, v1 = dtl[(2 * lane + 1) * 17 + h] + dtb;
    const float d0 = fmaxf(v0, 0.f) + 0.6931471805599453f * __builtin_amdgcn_logf(1.f + ex2(-LOG2E * fabsf(v0))), d1 = fmaxf(v1, 0.f) + 0.6931471805599453f * __builtin_amdgcn_logf(1.f + ex2(-LOG2E * fabsf(v1)));
    const float x0 = d0 * a, x1 = d1 * a;
    float sc = x0 + x1;
#pragma unroll
    for (int o = 1; o < 64; o <<= 1) { const float t = __shfl_up(sc, o); if (lane >= o) sc += t; }
    *(f32x2*)(DTA + ((t0 + 2 * lane) * 16 + h) * 2) = (f32x2){d0, sc - x1};
    *(f32x2*)(DTA + ((t0 + 2 * lane + 1) * 16 + h) * 2) = (f32x2){d1, sc};
  }
}
__device__ __forceinline__ void unit_dt64(LAS unsigned char* lds, const bf16_t* __restrict__ Hb, const bf16_t* __restrict__ WdtT, const float* __restrict__ dt_bias, const float* __restrict__ a_log,
                                          float* __restrict__ DTA, float* TOT, unsigned* FLG, const int unit) {
  const int tid = launder((int)threadIdx.x), lane = tid & 63, wave = __builtin_amdgcn_readfirstlane(tid >> 6);
  const int ck = unit >> 1, half = unit & 1;
  const size_t t0 = (size_t)ck * 128 + 64 * half;
  typedef float f32x2 __attribute__((ext_vector_type(2)));
  f32x4 acc[4];
#pragma unroll
  for (int rt = 0; rt < 4; ++rt) acc[rt] = (f32x4){0.f, 0.f, 0.f, 0.f};
  {
    const bf16_t* ap = Hb + (t0 + (lane & 15)) * D + 256 * wave + 8 * (lane >> 4);
    const bf16_t* bp = WdtT + (size_t)(lane & 15) * D + 256 * wave + 8 * (lane >> 4);
    bf16x8 bfr[8], afr[4][8];
#pragma unroll
    for (int ks = 0; ks < 8; ++ks) bfr[ks] = *(const bf16x8*)(bp + 32 * ks);
#pragma unroll
    for (int rt = 0; rt < 4; ++rt)
#pragma unroll
      for (int ks = 0; ks < 8; ++ks) afr[rt][ks] = *(const bf16x8*)(ap + (size_t)rt * 16 * D + 32 * ks);
#pragma unroll
    for (int rt = 0; rt < 4; ++rt)
#pragma unroll
      for (int ks = 0; ks < 8; ++ks) acc[rt] = __builtin_amdgcn_mfma_f32_16x16x32_bf16(afr[rt][ks], bfr[ks], acc[rt], 0, 0, 0);
  }
  LAS float* part = (LAS float*)lds;
  LAS float* dtl = (LAS float*)(lds + 32768);
  __syncthreads();
#pragma unroll
  for (int rt = 0; rt < 4; ++rt)
#pragma unroll
    for (int r = 0; r < 4; ++r) part[(wave * 64 + 16 * rt + 4 * (lane >> 4) + r) * 16 + (lane & 15)] = acc[rt][r];
  __syncthreads();
  { const int row = tid >> 3, c2 = 2 * (tid & 7);
    f32x2 sum = (f32x2){0.f, 0.f};
#pragma unroll
    for (int w = 0; w < 8; ++w) sum += *(const LAS f32x2*)(part + (w * 64 + row) * 16 + c2);
    dtl[row * 17 + c2] = sum[0]; dtl[row * 17 + c2 + 1] = sum[1]; }
  __syncthreads();
#pragma unroll 1
  for (int hh = 0; hh < 2; ++hh) {
    const int h = 2 * wave + hh;
    const float a = -ex2(a_log[h] * LOG2E), dtb = dt_bias[h];
    const float v = dtl[lane * 17 + h] + dtb;
    const float d = fmaxf(v, 0.f) + 0.6931471805599453f * __builtin_amdgcn_logf(1.f + ex2(-LOG2E * fabsf(v)));
    float sc = d * a;
#pragma unroll
    for (int o = 1; o < 64; o <<= 1) { const float t = __shfl_up(sc, o); if (lane >= o) sc += t; }
    if (half == 0) {
      if (lane == 63) { __hip_atomic_store(TOT + ck * 16 + h, sc, __ATOMIC_RELAXED, __HIP_MEMORY_SCOPE_AGENT); asm volatile("s_waitcnt vmcnt(0)" ::: "memory");
        __hip_atomic_fetch_add(FLG + ck, 1u, __ATOMIC_RELAXED, __HIP_MEMORY_SCOPE_AGENT); }
    } else {
      if (lane == 0) { unsigned sp = 0; while (__hip_atomic_load(FLG + ck, __ATOMIC_RELAXED, __HIP_MEMORY_SCOPE_AGENT) < 16u) { __builtin_amdgcn_s_sleep(1); if (++sp > (1u << 22)) break; } }
      sc += __hip_atomic_load(TOT + ck * 16 + h, __ATOMIC_RELAXED, __HIP_MEMORY_SCOPE_AGENT);
    }
    *(f32x2*)(DTA + ((t0 + lane) * 16 + h) * 2) = (f32x2){d, sc};
  }
}
constexpr int C_ST = 272;
constexpr int C_CM = 0, C_BM = 128 * C_ST, C_XS = C_BM + 32768, C_HS = C_XS + 32768, C_AC = C_HS + 64 * C_ST, C_DTS = C_AC + 512, C_SSS = C_DTS + 512, C_ZT = C_SSS + 1024, C_END = C_ZT + 2 * 16384;
__device__ __forceinline__ void unit_C(LAS unsigned char* lds, const bf16_t* __restrict__ P, const bf16_t* __restrict__ CONV, const float* __restrict__ DTA, const float* __restrict__ dskip,
                                       bf16_t* __restrict__ BR, float* __restrict__ SS, const int unit) {
  const int tid = launder((int)threadIdx.x), lane = tid & 63, wave = __builtin_amdgcn_readfirstlane(tid >> 6), r32 = lane & 31, hi = lane >> 5;
  const int b = unit >> 4, h = unit & 15, g = h >> 3;
  const float dsk = dskip[h];
  const int hf = wave >> 2, lg = hf ? 3 - (wave & 3) : (wave & 3), pt = wave & 1, nt = wave >> 1;
  const int l_lane = 32 * lg + r32;
  typedef float f32x2 __attribute__((ext_vector_type(2)));
  f32x16 hst;
#pragma unroll
  for (int r = 0; r < 16; ++r) hst[r] = 0.f;
  u32x4 cmr[4], bmr[4], xsr[2], zr[2]; f32x2 dab[4], dax[2]; float actot_r;
  const int prow = tid >> 4, pch = tid & 15, xrow = tid >> 3, xch = tid & 7;
  LAS float* acS = (LAS float*)(lds + C_AC); LAS float* dtS = (LAS float*)(lds + C_DTS); LAS float* ssS = (LAS float*)(lds + C_SSS);
  const int pxr = ((prow & 3) << 2) | ((prow >> 2) & 3), xxr = ((xrow & 3) << 2) | ((xrow >> 2) & 3);
#define C_LOAD(c_) do { const size_t t0_ = (size_t)b * S + 128 * (c_); \
    _Pragma("unroll") for (int i = 0; i < 4; ++i) { const size_t r_ = t0_ + prow + 32 * i; cmr[i] = *(const u32x4*)(CONV + r_ * 1536 + 1280 + g * 128 + pch * 8); \
      bmr[i] = *(const u32x4*)(CONV + r_ * 1536 + 1024 + g * 128 + pch * 8); dab[i] = *(const f32x2*)(DTA + (r_ * 16 + h) * 2); } \
    _Pragma("unroll") for (int i = 0; i < 2; ++i) { const size_t r_ = t0_ + xrow + 64 * i; xsr[i] = *(const u32x4*)(CONV + r_ * 1536 + h * 64 + xch * 8); dax[i] = *(const f32x2*)(DTA + (r_ * 16 + h) * 2); \
      zr[i] = *(const u32x4*)(P + r_ * LDP + P_Z + h * 64 + xch * 8); } \
    actot_r = DTA[((t0_ + 127) * 16 + h) * 2 + 1]; } while (0)
  C_LOAD(0);
#pragma unroll 1
  for (int c = 0; c < 16; ++c) {
    const size_t t0 = (size_t)b * S + 128 * c;
#pragma unroll
    for (int i = 0; i < 4; ++i) {
      const int row = prow + 32 * i;
      *(LAS u32x4*)(lds + C_CM + row * C_ST + pch * 16) = cmr[i];
      *(LAS u32x4*)(lds + C_BM + 256 * row + 16 * (pch ^ pxr)) = bmr[i];
    }
#pragma unroll
    for (int i = 0; i < 2; ++i) {
      const int row = xrow + 64 * i; const float dtv = dax[i].x, dsv = dtv * ex2((actot_r - dax[i].y) * LOG2E);
      u32x4 a, s2;
      a.x = cvtpk(bflo(xsr[i].x) * dtv, bfhi(xsr[i].x) * dtv); a.y = cvtpk(bflo(xsr[i].y) * dtv, bfhi(xsr[i].y) * dtv); a.z = cvtpk(bflo(xsr[i].z) * dtv, bfhi(xsr[i].z) * dtv); a.w = cvtpk(bflo(xsr[i].w) * dtv, bfhi(xsr[i].w) * dtv);
      s2.x = cvtpk(bflo(xsr[i].x) * dsv, bfhi(xsr[i].x) * dsv); s2.y = cvtpk(bflo(xsr[i].y) * dsv, bfhi(xsr[i].y) * dsv); s2.z = cvtpk(bflo(xsr[i].z) * dsv, bfhi(xsr[i].z) * dsv); s2.w = cvtpk(bflo(xsr[i].w) * dsv, bfhi(xsr[i].w) * dsv);
      *(LAS u32x4*)(lds + C_XS + 256 * row + 16 * (xch ^ xxr)) = a;
      *(LAS u32x4*)(lds + C_XS + 256 * row + 16 * ((8 + xch) ^ xxr)) = s2;
      *(LAS u32x4*)(lds + C_ZT + (c & 1) * 16384 + 128 * row + 16 * (xch ^ (row & 7))) = zr[i];
    }
    if (pch == 0) {
#pragma unroll
      for (int i = 0; i < 4; ++i) { acS[prow + 32 * i] = dab[i].y; dtS[prow + 32 * i] = dab[i].x; }
    }
    if (c > 0) {
#pragma unroll
      for (int r = 0; r < 16; ++r) *(LAS unsigned short*)(lds + C_HS + (32 * pt + crow(r, hi)) * C_ST + (32 * nt + r32) * 2) = (unsigned short)f2bf(hst[r]);
    }
    const float actot = actot_r;
    __syncthreads();
    if (c + 1 < 16) C_LOAD(c + 1);
    const LaneB LB = lane_b(launder(lane));
    const unsigned xa0 = LB.T0 + 64u * ((unsigned)hf ^ LB.q), xa1 = LB.T1 + 64u * ((unsigned)hf ^ LB.q);
    const LAS unsigned char* cmb = lds + C_CM + l_lane * C_ST + 16 * hi;
    bf16x8 cf[8];
#pragma unroll
    for (int ks = 0; ks < 8; ++ks) cf[ks] = *(const LAS bf16x8*)(cmb + ks * 32);
    f32x16 yo;
#pragma unroll
    for (int r = 0; r < 16; ++r) yo[r] = 0.f;
    if (c > 0) {
      const LAS unsigned char* hb_ = lds + C_HS + (32 * hf + r32) * C_ST + 16 * hi;
#pragma unroll
      for (int kh = 0; kh < 2; ++kh) {
        bf16x8 ha[4];
#pragma unroll
        for (int ks = 0; ks < 4; ++ks) ha[ks] = *(const LAS bf16x8*)(hb_ + (4 * kh + ks) * 32);
        __builtin_amdgcn_sched_barrier(0);
#pragma unroll
        for (int ks = 0; ks < 4; ++ks) yo = __builtin_amdgcn_mfma_f32_32x32x16_bf16(ha[ks], cf[4 * kh + ks], yo, 0, 0, 0);
      }
    }
    f32x16 yd[1];
#pragma unroll
    for (int r = 0; r < 16; ++r) yd[0][r] = 0.f;
    const float al = acS[l_lane];
#pragma unroll 1
    for (int st = 0; st <= lg; ++st) {
      f32x16 sa;
#pragma unroll
      for (int r = 0; r < 16; ++r) sa[r] = 0.f;
      const LAS unsigned char* bb_ = lds + C_BM + 256 * (32 * st + r32);
#pragma unroll
      for (int kh = 0; kh < 4; ++kh) {
        bf16x8 ba[2];
#pragma unroll
        for (int ks = 0; ks < 2; ++ks) ba[ks] = *(const LAS bf16x8*)(bb_ + 16u * ((unsigned)(2 * (2 * kh + ks) + hi) ^ LB.xr));
        __builtin_amdgcn_sched_barrier(0);
#pragma unroll
        for (int ks = 0; ks < 2; ++ks) sa = __builtin_amdgcn_mfma_f32_32x32x16_bf16(ba[ks], cf[2 * kh + ks], sa, 0, 0, 0);
      }
#pragma unroll
      for (int r = 0; r < 16; ++r) { const int si = 32 * st + crow(r, hi); const float dec = ex2((al - acS[si]) * LOG2E); sa[r] = (si <= l_lane) ? sa[r] * dec : 0.f; }
      { const LAS unsigned char* xv = lds + C_XS + 4096 * (2 * st);
        { const u32x2 f0 = tr_rd(xv + xa0), f1 = tr_rd(xv + xa1); const u32x4 a_ = (u32x4){f0.x, f0.y, f1.x, f1.y};
          yd[0] = __builtin_amdgcn_mfma_f32_32x32x16_bf16(__builtin_bit_cast(bf16x8, a_), pack8<0>(sa), yd[0], 0, 0, 0); }
        __builtin_amdgcn_sched_barrier(0);
        { const u32x2 f0 = tr_rd(xv + 4096 + xa0), f1 = tr_rd(xv + 4096 + xa1); const u32x4 a_ = (u32x4){f0.x, f0.y, f1.x, f1.y};
          yd[0] = __builtin_amdgcn_mfma_f32_32x32x16_bf16(__builtin_bit_cast(bf16x8, a_), pack8<1>(sa), yd[0], 0, 0, 0); } }
    }
    {
      const float cdec = ex2(actot * LOG2E);
      hst = hst * cdec;
      const unsigned sx0 = LB.N0 + 64u * ((unsigned)(2 + pt) ^ LB.q), sx1 = LB.N1 + 64u * ((unsigned)(2 + pt) ^ LB.q);
      const unsigned sb0 = LB.N0 + 64u * ((unsigned)nt ^ LB.q), sb1 = LB.N1 + 64u * ((unsigned)nt ^ LB.q);
      const LAS unsigned char* xv = lds + C_XS; const LAS unsigned char* bv = lds + C_BM;
#pragma unroll
      for (int k16 = 0; k16 < 8; ++k16) {
        const u32x2 fx0 = tr_rd(xv + 4096 * k16 + sx0), fx1 = tr_rd(xv + 4096 * k16 + sx1), fb0 = tr_rd(bv + 4096 * k16 + sb0), fb1 = tr_rd(bv + 4096 * k16 + sb1);
        const u32x4 a_ = (u32x4){fx0.x, fx0.y, fx1.x, fx1.y}, b_ = (u32x4){fb0.x, fb0.y, fb1.x, fb1.y};
        hst = __builtin_amdgcn_mfma_f32_32x32x16_bf16(__builtin_bit_cast(bf16x8, a_), __builtin_bit_cast(bf16x8, b_), hst, 0, 0, 0);
      }
    }
    {
      const float el = ex2(al * LOG2E), dl = dsk / dtS[l_lane];
      const size_t row = t0 + l_lane;
      float ssq = 0.f;
#pragma unroll
      for (int g4 = 0; g4 < 4; ++g4) {
        const int p0_ = 32 * hf + 8 * g4 + 4 * hi;
        LAS u32x2* zp = (LAS u32x2*)(lds + C_ZT + (c & 1) * 16384 + 128 * l_lane + 16 * ((4 * hf + g4) ^ (l_lane & 7)) + 8 * hi);
        const u32x2 zw = *zp;
        float yv[4];
        const u32x2 xw = *(const LAS u32x2*)(lds + C_XS + 256 * l_lane + 16u * ((unsigned)(4 * hf + g4) ^ LB.xr) + 8 * hi);
        const float xd[4] = {bflo(xw.x), bfhi(xw.x), bflo(xw.y), bfhi(xw.y)};
#pragma unroll
        for (int i = 0; i < 4; ++i) yv[i] = yd[0][4 * g4 + i] + el * yo[4 * g4 + i] + dl * xd[i];
        const float y0 = yv[0] * silu_fast(bflo(zw.x)), y1 = yv[1] * silu_fast(bfhi(zw.x)), y2 = yv[2] * silu_fast(bflo(zw.y)), y3 = yv[3] * silu_fast(bfhi(zw.y));
        ssq += (y0 * y0 + y1 * y1) + (y2 * y2 + y3 * y3);
        u32x2 ov; ov.x = cvtpk(y0, y1); ov.y = cvtpk(y2, y3);
        *zp = ov;
      }
      ssq += __shfl_xor(ssq, 32);
      if (hi == 0) ssS[hf * 128 + l_lane] = ssq;
    }
    __syncthreads();
    if (tid < 128) SS[(t0 + tid) * 16 + h] = ssS[tid] + ssS[128 + tid];
#pragma unroll
    for (int i = 0; i < 2; ++i) { const int row = xrow + 64 * i;
      *(u32x4*)(BR + (t0 + row) * LDBR + 2048 + h * 64 + xch * 8) = *(const LAS u32x4*)(lds + C_ZT + (c & 1) * 16384 + 128 * row + 16 * (xch ^ (row & 7))); }
  }
#undef C_LOAD
}

#define XB_TMO      128
#define XB_XCNT(j)  (256  + 64 * (j))
#define XB_XSUB(j)  (1280 + 64 * (j))
#define XB_XGEN(j)  (2304 + 64 * (j))
#define XB_TOP      3328
#define XB_TOPGEN   3392
#define XCD_BAR_WORDS 3456
#define XB_SPIN_CAP (1u << 18)
__device__ __forceinline__ unsigned xb_ld(unsigned* p)              { return __hip_atomic_load(p, __ATOMIC_RELAXED, __HIP_MEMORY_SCOPE_AGENT); }
__device__ __forceinline__ unsigned xb_add(unsigned* p, unsigned v) { return __hip_atomic_fetch_add(p, v, __ATOMIC_RELAXED, __HIP_MEMORY_SCOPE_AGENT); }
__device__ __forceinline__ unsigned xb_xcc_id() { return (unsigned)__builtin_amdgcn_s_getreg((3 << 11) | 20) & 0xFu; }
#define XB_SPIN(cond, bar) do { unsigned _sp = 0; while (cond) { __builtin_amdgcn_s_sleep(1); \
    if ((++_sp & 255u) == 0u) { if (xb_ld(&(bar)[XB_TMO])) break; if (_sp > XB_SPIN_CAP) { atomicAdd(&(bar)[XB_TMO], 1u); break; } } } } while (0)
struct XcdBarrier { unsigned* bar; unsigned x; volatile LAS unsigned* st; };
__device__ __forceinline__ XcdBarrier xcd_barrier_post(unsigned* bar, volatile LAS unsigned* st) {
    XcdBarrier b; b.bar = bar; b.x = xb_xcc_id(); b.st = st;
    if (threadIdx.x == 0) (void)xb_add(&bar[XB_XCNT(b.x)], 1u);
    return b;
}
__device__ __forceinline__ void xcd_barrier_complete(unsigned* bar, unsigned x, unsigned& nloc, unsigned& nx) {
    const unsigned G = gridDim.x * gridDim.y * gridDim.z;
    unsigned sum, cnt, mine, sp = 0u;
    for (;;) {
        sum = 0u; cnt = 0u; mine = 0u;
#pragma unroll 1
        for (unsigned j = 0; j < 16; ++j) { const unsigned c = xb_ld(&bar[XB_XCNT(j)]); sum += c; cnt += (c > 0u) ? 1u : 0u; mine = (j == x) ? c : mine; }
        if (sum == G) break;
        __builtin_amdgcn_s_sleep(1);
        if ((++sp & 255u) == 0u) { if (xb_ld(&bar[XB_TMO])) break; if (sp > XB_SPIN_CAP) { atomicAdd(&bar[XB_TMO], 1u); break; } }
    }
    nloc = mine > 0u ? mine : 1u; nx = cnt > 0u ? cnt : 1u;
}
__device__ __forceinline__ void xcd_barrier(const XcdBarrier& b) {
    asm volatile("s_waitcnt vmcnt(0)" ::: "memory");
    __syncthreads();
    if (threadIdx.x == 0) {
        unsigned* bar = b.bar;
        asm volatile("" : "+s"(bar));
        __builtin_amdgcn_s_waitcnt(0);
        unsigned nloc = b.st[0], nx = b.st[1];
        if (nloc == 0u) { xcd_barrier_complete(bar, b.x, nloc, nx); b.st[0] = nloc; b.st[1] = nx; }
        const unsigned old = xb_add(&bar[XB_XSUB(b.x)], 1u);
        const unsigned gen = old / nloc;
        if (old + 1u == (gen + 1u) * nloc) {
            __builtin_amdgcn_fence(__ATOMIC_RELEASE, "agent");
            asm volatile("s_waitcnt vmcnt(0)" ::: "memory");
            const unsigned og = xb_add(&bar[XB_TOP], 1u);
            const unsigned tg = og / nx;
            if (og + 1u == (tg + 1u) * nx) xb_add(&bar[XB_TOPGEN], 1u);
            else XB_SPIN(xb_ld(&bar[XB_TOPGEN]) == tg, bar);
            __builtin_amdgcn_fence(__ATOMIC_ACQUIRE, "agent");
            xb_add(&bar[XB_XGEN(b.x)], 1u);
            asm volatile("s_waitcnt vmcnt(0)" ::: "memory");
        } else {
            XB_SPIN(xb_ld(&bar[XB_XGEN(b.x)]) == gen, bar);
            __builtin_amdgcn_fence(__ATOMIC_ACQUIRE, "agent");
            asm volatile("s_waitcnt vmcnt(0)" ::: "memory");
        }
    }
    __syncthreads();
}

__global__ void __launch_bounds__(NTHREADS, 2) mega(Args args) {
  extern __shared__ __attribute__((aligned(16))) unsigned char lds_raw[];
  LAS unsigned char* lds = (LAS unsigned char*)lds_raw;
  cg::grid_group grid = cg::this_grid();
  const int G = gridDim.x, bx = blockIdx.x;
#define LANE() (launder((int)threadIdx.x) & 63)
#define GW() (bx * NWAVES + __builtin_amdgcn_readfirstlane(launder((int)threadIdx.x) >> 6))
  const int NGW = G * NWAVES;
  unsigned char* ws = args.ws;
  const float* x = args.in[0];
  const float* norm_w = args.in[1];
  const float* w_in = args.in[2];
  const float* ssd_norm_w = args.in[11];
  const float* w_branch = args.in[16];
  const float* w_out = args.in[17];
  const float* final_norm_w = args.in[19];
  bf16_t* WinT = (bf16_t*)(ws + WS_WIN); bf16_t* WbrT = (bf16_t*)(ws + WS_WBR); bf16_t* WoutT = (bf16_t*)(ws + WS_WOUT);
  bf16_t* Hb = (bf16_t*)(ws + WS_H); bf16_t* PROJ = (bf16_t*)(ws + WS_PROJ); float* DT = (float*)(ws + WS_DT);
  bf16_t* BR = (bf16_t*)(ws + WS_BR); float* SS = (float*)(ws + WS_SS); float* MACC = (float*)(ws + WS_MACC); bf16_t* MERGED = (bf16_t*)(ws + WS_MERGED);
  float* X1 = (float*)(ws + WS_X1); float* X2 = (float*)(ws + WS_X2);
  signed char* H8 = (signed char*)(ws + WS_H8); float* SH = (float*)(ws + WS_SH); signed char* W8 = (signed char*)(ws + WS_W8); float* SW = (float*)(ws + WS_SW);
  const int lo = args.ph_lo, hi = args.ph_hi;
  if (threadIdx.x < 16) ((volatile LAS unsigned*)(lds + LDS_BYTES - 64))[threadIdx.x] = 0u;
  __syncthreads();
  const XcdBarrier xbar = xcd_barrier_post((unsigned*)(ws + WS_CTL) + 1024, (volatile LAS unsigned*)(lds + LDS_BYTES - 32));
#define IN(k) (lo <= (k) && (k) < hi)
  if (lo < 0) grid.sync();
#define SEAM(k) do { if (IN(k) && IN((k) + 1)) xcd_barrier(xbar); } while (0)

  if (IN(PH_CONV)) {
    constexpr int NBLK_IN = P_MG / 32;
    constexpr int I_IN = 32 * 256, I_BR = 64 * (D / 32), I_OUT = 32 * (D / 32), I_L = I_IN + I_BR + I_OUT;
    const int lane = LANE(); const int gw = GW();
    for (int bi = bx; bi < 768; bi += G) { const int l = bi / 384, it8 = bi % 384; gate_w8_item(lds, w_in + (size_t)l * D * NIN, W8 + (size_t)l * N8 * D, SW + l * N8, it8); }
    for (int rep = 0; rep < REP_CONVW; ++rep)
    for (int it = gw; it < 2 * I_L; it += NGW) {
      const int l = it / I_L; int r = it % I_L;
      if (r < I_IN) { const int kb_i = r >> 8, nbp = r & 255, nb = 8 * pn_of_j(nbp >> 3) + (nbp & 7);
        conv_item(w_in + (size_t)l * D * NIN, NIN, D, WinT + (size_t)l * NPAD * D, 0, nullptr, kb_i * NBLK_IN + nb, NBLK_IN, lane); continue; } r -= I_IN;
      if (r < I_BR) { conv_item(w_branch + (size_t)l * 4096 * D, D, 4096, WbrT + (size_t)l * D * 4096, 2, ssd_norm_w + l * 1024, r, D / 32, lane); continue; } r -= I_BR;
      conv_item(w_out + (size_t)l * D * D, D, D, WoutT + (size_t)l * D * D, 1, nullptr, r, D / 32, lane);
    }
  }
  if (IN(PH_CONV)) {
    const int gt = bx * NTHREADS + launder((int)threadIdx.x);
    if (gt < 2 * D) {
      const int l = gt / D, k = gt % D; const float* src = w_in + (size_t)l * D * NIN + (size_t)k * NIN + 8192;
      bf16_t* dst = (bf16_t*)(ws + WS_WDT) + (size_t)l * 16 * D + k;
#pragma unroll
      for (int q = 0; q < 4; ++q) { const f32x4 v = *(const f32x4*)(src + 4 * q); dst[(4 * q + 0) * D] = (bf16_t)f2bf(v[0]); dst[(4 * q + 1) * D] = (bf16_t)f2bf(v[1]); dst[(4 * q + 2) * D] = (bf16_t)f2bf(v[2]); dst[(4 * q + 3) * D] = (bf16_t)f2bf(v[3]); }
    }
  }
  if (IN(PH_CONV)) { const int lane = LANE(); const int gw = GW(); for (int m = gw; m < T; m += NGW) norm_row_bf16(x + (size_t)m * D, norm_w, Hb + (size_t)m * D, H8 + (size_t)m * D, SH + m, lane); }
  SEAM(PH_CONV);
#pragma unroll 1
  for (int l = 0; l < 2; ++l) {
    const int pb = PH_L0 + l * PH_PER_LAYER;
    const void* xin = (l == 0) ? (const void*)x : (const void*)X1; void* xout = (l == 0) ? (void*)X1 : (void*)X2;
    if (IN(pb + 0) && l > 0) { const int lane = LANE(); const int gw = GW(); for (int m = gw; m < T; m += NGW) norm_row_bf16b((const bf16_t*)X1 + (size_t)m * D, norm_w + (size_t)l * D, Hb + (size_t)m * D, H8 + (size_t)m * D, SH + m, lane); }
    if (l > 0) SEAM(pb + 0);
    if (IN(pb + 1)) {
      SchedInproj Sd{(const char*)Hb, (const char*)(WinT + (size_t)l * NPAD * D), G, bx};
      EpiProj E{PROJ, ws + WS_G8};
      SchedGate8 Sg{(const char*)H8, (const char*)(W8 + (size_t)l * N8 * D), G, bx};
      EpiGate8 Eg{ws + WS_G8, SH, SW + l * N8, PROJ};
      const bool gates_first = ((bx >> 3) & 1) != 0;
#pragma unroll 1
      for (int s = 0; s < 2; ++s) {
        if ((s == 0) != gates_first) pg8::gemm_phase(lds, D, D, Sd, E);
        else pg8::gemm_phase(lds, D / 2, D / 2, Sg, Eg);
      }
    }
    SEAM(pb + 1);
    if (IN(pb + 2) && FAST_C) {
      for (int rep = 0; rep < REP_PREMIX; ++rep)
      if (G >= 256) {
        if (bx < 128) unit_dt64(lds, Hb, (const bf16_t*)(ws + WS_WDT) + (size_t)l * 16 * D, args.in[8] + l * 16, args.in[9] + l * 16, (float*)(ws + WS_DTA),
                                (float*)(ws + WS_CTL + 131072) + l * 1024, (unsigned*)(ws + WS_CTL) + 4608 + 64 * l, bx);
        else if (bx < 256) unit_conv<4>(PROJ, args.in[6] + (size_t)l * 4 * 1536, args.in[7] + l * 1536, (bf16_t*)(ws + WS_CONV), 4 * (bx - 128));
      } else if (G >= 235) {
        if (bx < 64) unit_dt(lds, Hb, (const bf16_t*)(ws + WS_WDT) + (size_t)l * 16 * D, args.in[8] + l * 16, args.in[9] + l * 16, (float*)(ws + WS_DTA), bx);
        else { const int u0 = 3 * (bx - 64);
          if (u0 + 3 <= 512) unit_conv<3>(PROJ, args.in[6] + (size_t)l * 4 * 1536, args.in[7] + l * 1536, (bf16_t*)(ws + WS_CONV), u0);
          else if (u0 < 512) { for (int u = u0; u < 512; ++u) unit_conv<1>(PROJ, args.in[6] + (size_t)l * 4 * 1536, args.in[7] + l * 1536, (bf16_t*)(ws + WS_CONV), u); } }
      } else
      for (int u = bx; u < 576; u += G) {
        if (u < 512) unit_conv<1>(PROJ, args.in[6] + (size_t)l * 4 * 1536, args.in[7] + l * 1536, (bf16_t*)(ws + WS_CONV), u);
        else unit_dt(lds, Hb, (const bf16_t*)(ws + WS_WDT) + (size_t)l * 16 * D, args.in[8] + l * 16, args.in[9] + l * 16, (float*)(ws + WS_DTA), u - 512);
      }
    }
    SEAM(pb + 2);
    if (IN(pb + 3)) {
      constexpr int NU_C = FAST_C ? 64 : 0, NU_A = FAST_A ? 512 : 0, NU_B = FAST_B ? 256 : 0, NU_D = FAST_D ? 256 : 0;
      const float lam_init = (l == 0) ? 0.2f : (float)(0.8 - 0.6 * 0.7408182206817179);
      float lam;
      { const float* dl = args.in[3] + l * 256; float s1 = 0.f, s2 = 0.f;
        for (int j = 0; j < 64; ++j) { s1 = fmaf(dl[j], dl[64 + j], s1); s2 = fmaf(dl[128 + j], dl[192 + j], s2); }
        lam = ex2(s1 * LOG2E) - ex2(s2 * LOG2E) + lam_init;
        lam = __int_as_float(__builtin_amdgcn_readfirstlane(__float_as_int(lam))); }
      volatile LAS int* slot = (volatile LAS int*)(lds + LDS_BYTES - 64);
      for (int rep = 0; rep < REP_MIX; ++rep) {
      unsigned* ctr = (unsigned*)(ws + WS_CTL) + 64 * (1 + l + 2 * rep);
      for (;;) {
        __syncthreads();
        if (threadIdx.x == 0) *slot = (int)atomicAdd(ctr, 1u);
        __syncthreads();
        int u = *slot;
        if (u >= NU_C + NU_A + NU_B + NU_D) break;
        if (u < NU_C) { unit_C(lds, PROJ, (const bf16_t*)(ws + WS_CONV), (const float*)(ws + WS_DTA), args.in[10] + l * 16, BR, SS, u); continue; } u -= NU_C;
        int ia = -1, ib = -1, idd = -1;
        if (u < 896) { const int grp = u / 7, k = u % 7; if (k < 3) ia = 3 * grp + k; else if (k < 5) ib = 2 * grp + (k - 3); else idd = 2 * grp + (k - 5); }
        else ia = 384 + (u - 896);
        if (ia >= 0) { unit_A(lds, PROJ, args.in[18], args.in[4] + l * 128, lam, l, BR, ia); continue; }
        if (ib >= 0) { unit_B(lds, PROJ, args.in[18], args.in[5] + l * 16, BR, ib); continue; }
        unit_D(lds, PROJ, args.in[12] + (size_t)l * 31 * 1024, args.in[13] + l * 1024, args.in[14] + l * 1024, args.in[15] + l * 1024, BR, idd);
      }
      }
    }
    SEAM(pb + 3);
    if (IN(pb + 4)) {
      SchedMergeMP Sd{(const char*)BR, (const char*)(WbrT + (size_t)l * D * 4096), G, bx};
      EpiMergeMP E{ws + WS_G8, SS, MERGED, (LAS float*)(lds + 131072)};
      for (int rep = 0; rep < REP_MERGE; ++rep) pg8::gemm_phase(lds, LDBR, 4096, Sd, E);
    }
    SEAM(pb + 4);
    if (IN(pb + 5)) {
      SchedOut Sd{(const char*)MERGED, (const char*)(WoutT + (size_t)l * D * D), G, bx};
      EpiOut E{xin, xout, l};
      for (int rep = 0; rep < REP_OUT; ++rep) pg8::gemm_phase(lds, D, D, Sd, E);
    }
    SEAM(pb + 5);
  }
  if (IN(PH_FINAL)) { const int lane = LANE(); const int gw = GW(); for (int m = gw; m < T; m += NGW) norm_row_f32b((const bf16_t*)X2 + (size_t)m * D, final_norm_w, args.out + (size_t)m * D, lane); }
#undef IN
#undef SEAM
}
}

extern "C" void kernel_launch(void* const* d_in, const int* in_sizes, int n_in, void* d_out, int out_size, void* d_ws, size_t ws_size, hipStream_t stream) {
  static int grid = 0;
  if (grid == 0) {
    int dev = 0, cus = 0, per_cu = 0;
    hipGetDevice(&dev);
    hipDeviceGetAttribute(&cus, hipDeviceAttributeMultiprocessorCount, dev);
    hipFuncSetAttribute((const void*)mega, hipFuncAttributeMaxDynamicSharedMemorySize, LDS_BYTES);
    hipOccupancyMaxActiveBlocksPerMultiprocessor(&per_cu, (const void*)mega, NTHREADS, LDS_BYTES);
    if (per_cu < 1) per_cu = 1;
    grid = cus * per_cu;
    if (ws_size < WS_END) fprintf(stderr, "kernel_launch: workspace too small: %zu < %zu\n", ws_size, (size_t)WS_END);
  }
  unsigned char* ws = (unsigned char*)d_ws;

  Args a{};
  for (int i = 0; i < 20; ++i) a.in[i] = (const float*)d_in[i];
  a.out = (float*)d_out; a.ws = ws;
  auto launch = [&](int lo, int hi) {
    a.ph_lo = lo; a.ph_hi = hi;
    void* kargs[] = {&a};
    hipError_t e = hipLaunchCooperativeKernel((const void*)mega, dim3(grid), dim3(NTHREADS), kargs, LDS_BYTES, stream);
    if (e != hipSuccess) fprintf(stderr, "cooperative launch failed: %s (grid %d)\n", hipGetErrorString(e), grid);
  };
  hipMemsetAsync(ws + WS_CTL, 0, 32768, stream);
  launch(0, PH_COUNT);
}
```
